# Optimizing an MI355X kernel written in HIP

```python
import jax, jax.numpy as jnp
from jax import lax
import numpy as np

D_MODEL = 2048
BATCH = 2
SEQ = 4096
DEPTH = 1
DEC_BATCH = 32
DEC_SEQ = 32
PAST_LEN = 2048

CHUNK = 64
D_CONV = D_MODEL // 2
CONV_WIDTH = 3
H_ATTN = 8
HD_ATTN = 128
D_ATTN = H_ATTN * HD_ATTN
D_MIX = D_CONV + D_ATTN
D_IN = 3 * D_CONV + 3 * D_ATTN + H_ATTN
N_MEM = 256
H_X = 4
HD_X = 128
D_X = H_X * HD_X
D_FF = 4 * D_MODEL
Q_BLOCK = 128
RMS_EPS = 1e-6
FORGET_BIAS_INIT = 3.0

kernel_name = "hybrid_conv_fox_stream_step"


def rmsnorm(x, g):
    xf = x.astype(jnp.float32)
    y = xf * lax.rsqrt(jnp.mean(xf * xf, axis=-1, keepdims=True) + RMS_EPS)
    return (y * g.astype(jnp.float32)).astype(x.dtype)


def project(xn, w_in, b_f):
    N, T, _ = xn.shape
    z = xn @ w_in
    o1, o2, o3 = D_CONV, 2 * D_CONV, 3 * D_CONV
    o4, o5, o6 = o3 + D_ATTN, o3 + 2 * D_ATTN, o3 + 3 * D_ATTN
    gb, gc, hin = z[..., :o1], z[..., o1:o2], z[..., o2:o3]
    q = z[..., o3:o4].reshape(N, T, H_ATTN, HD_ATTN)
    k = z[..., o4:o5].reshape(N, T, H_ATTN, HD_ATTN)
    v = z[..., o5:o6].reshape(N, T, H_ATTN, HD_ATTN)
    logf = jax.nn.log_sigmoid(z[..., o6:].astype(jnp.float32) + b_f.astype(jnp.float32))
    return gb, gc, hin, q, k, v, logf


def short_conv(u, buf, w):
    T = u.shape[1]
    up = jnp.concatenate([buf, u], axis=1)
    y = w[0] * up[:, 0:T]
    for j in range(1, CONV_WIDTH):
        y = y + w[j] * up[:, j:j + T]
    return y, up[:, -(CONV_WIDTH - 1):]


def fox_attention(q, k, v, cq, ck, q_pos, k_pos):
    N, Tq, H, D = q.shape
    blk = Q_BLOCK if Tq % Q_BLOCK == 0 else Tq
    nb = Tq // blk
    scale = HD_ATTN ** -0.5
    qb = q.reshape(N, nb, blk, H, D).transpose(1, 0, 2, 3, 4)
    cqb = cq.reshape(N, nb, blk, H).transpose(1, 0, 3, 2)
    pb = q_pos.reshape(nb, blk)
    ckT = ck.transpose(0, 2, 1)[:, :, None, :]

    def one_block(args):
        qi, ci, pi = args
        s = jnp.einsum('nqhd,nkhd->nhqk', qi, k, preferred_element_type=jnp.float32) * scale
        s = s + (ci[..., None] - ckT)
        mask = k_pos[None, :] <= pi[:, None]
        s = jnp.where(mask, s, -jnp.inf)
        p = jax.nn.softmax(s, axis=-1)
        return jnp.einsum('nhqk,nkhd->nqhd', p.astype(v.dtype), v)

    out = lax.map(one_block, (qb, cqb, pb))
    return out.transpose(1, 0, 2, 3, 4).reshape(N, Tq, H * D)


def parallel_mixer(xn, conv_buf, k_past, v_past, logf_past, w_in, b_f, conv_w, g_conv_out, g_attn_out, w_out):
    N, T, _ = xn.shape
    P = k_past.shape[1]
    gb, gc, hin, q, k, v, logf = project(xn, w_in, b_f)
    yc, conv_new = short_conv(gc * hin, conv_buf, conv_w)
    yc = gb * yc
    k_all = jnp.concatenate([k_past, k], axis=1)
    v_all = jnp.concatenate([v_past, v], axis=1)
    c_all = jnp.cumsum(jnp.concatenate([logf_past.astype(jnp.float32), logf], axis=1), axis=1)
    k_pos = jnp.arange(P + T)
    q_pos = P + jnp.arange(T)
    ya = fox_attention(q, k_all, v_all, c_all[:, P:], c_all, q_pos, k_pos)
    y = jnp.concatenate([rmsnorm(yc, g_conv_out), rmsnorm(ya, g_attn_out)], axis=-1) @ w_out
    return y, conv_new, k, v, logf


def memory_kv(mem, g_mem, w_xkv):
    N = mem.shape[0]
    kv = rmsnorm(mem, g_mem) @ w_xkv
    mk = kv[..., :D_X].reshape(N, N_MEM, H_X, HD_X)
    mv = kv[..., D_X:].reshape(N, N_MEM, H_X, HD_X)
    return mk, mv


def cross_attention(xn, mk, mv, w_xq, w_xo):
    N, T, _ = xn.shape
    q = (xn @ w_xq).reshape(N, T, H_X, HD_X)
    s = jnp.einsum('nqhd,nkhd->nhqk', q, mk, preferred_element_type=jnp.float32) * (HD_X ** -0.5)
    p = jax.nn.softmax(s, axis=-1)
    o = jnp.einsum('nhqk,nkhd->nqhd', p.astype(mv.dtype), mv).reshape(N, T, D_X)
    return o @ w_xo


def sq_relu_mlp(xn, w_up, w_down):
    return jnp.square(jax.nn.relu(xn @ w_up)) @ w_down


def setup_inputs(seed: int = 0) -> dict:
    key = jax.random.key(seed)
    ks = jax.random.split(key, 32)
    f32 = jnp.float32

    def nrm(k, shape, scale):
        return jax.random.normal(k, shape, f32) * scale

    def gain(k, shape):
        return 1.0 + 0.01 * jax.random.normal(k, shape, f32)

    return {
        "x_prompt": nrm(ks[0], (BATCH, SEQ, D_MODEL), 1.0),
        "x_sample": nrm(ks[1], (DEC_BATCH, DEC_SEQ, D_MODEL), 1.0),
        "cache_k": nrm(ks[2], (DEPTH, DEC_BATCH, PAST_LEN, H_ATTN, HD_ATTN), 1.0),
        "cache_v": nrm(ks[3], (DEPTH, DEC_BATCH, PAST_LEN, H_ATTN, HD_ATTN), 1.0),
        "cache_logf": jax.nn.log_sigmoid(FORGET_BIAS_INIT + nrm(ks[4], (DEPTH, DEC_BATCH, PAST_LEN, H_ATTN), 1.0)),
        "cache_conv": nrm(ks[5], (DEPTH, DEC_BATCH, CONV_WIDTH - 1, D_CONV), 1.0),
        "cache_mem_k": nrm(ks[6], (DEPTH, DEC_BATCH, N_MEM, H_X, HD_X), 1.0),
        "cache_mem_v": nrm(ks[7], (DEPTH, DEC_BATCH, N_MEM, H_X, HD_X), 1.0),
        "mem_prompt": nrm(ks[8], (BATCH, N_MEM, D_MODEL), 1.0),
        "g_mix": gain(ks[9], (DEPTH, D_MODEL)),
        "w_in": nrm(ks[10], (DEPTH, D_MODEL, D_IN), D_MODEL ** -0.5),
        "b_f": FORGET_BIAS_INIT + nrm(ks[11], (DEPTH, H_ATTN), 0.1),
        "conv_w": nrm(ks[12], (DEPTH, CONV_WIDTH, D_CONV), CONV_WIDTH ** -0.5),
        "g_conv_out": gain(ks[13], (DEPTH, D_CONV)),
        "g_attn_out": gain(ks[14], (DEPTH, D_ATTN)),
        "w_out": nrm(ks[15], (DEPTH, D_MIX, D_MODEL), D_MIX ** -0.5),
        "g_xattn": gain(ks[16], (DEPTH, D_MODEL)),
        "g_mem": gain(ks[17], (DEPTH, D_MODEL)),
        "w_xq": nrm(ks[18], (DEPTH, D_MODEL, D_X), D_MODEL ** -0.5),
        "w_xkv": nrm(ks[19], (DEPTH, D_MODEL, 2 * D_X), D_MODEL ** -0.5),
        "w_xo": nrm(ks[20], (DEPTH, D_X, D_MODEL), D_X ** -0.5),
        "g_mlp": gain(ks[21], (DEPTH, D_MODEL)),
        "w_up": nrm(ks[22], (DEPTH, D_MODEL, D_FF), D_MODEL ** -0.5),
        "w_down": nrm(ks[23], (DEPTH, D_FF, D_MODEL), D_FF ** -0.5),
        "g_final": gain(ks[24], (D_MODEL,)),
    }


def reference(x_prompt, x_sample, cache_k, cache_v, cache_logf, cache_conv, cache_mem_k, cache_mem_v, mem_prompt,
              g_mix, w_in, b_f, conv_w, g_conv_out, g_attn_out, w_out, g_xattn, g_mem, w_xq, w_xkv, w_xo,
              g_mlp, w_up, w_down, g_final):
    xp, xs = x_prompt, x_sample
    Bp = xp.shape[0]
    kp_l, vp_l, fp_l, cp_l, mkp_l, mvp_l = [], [], [], [], [], []
    ks_l, vs_l, fs_l, cs_l = [], [], [], []
    for l in range(DEPTH):
        mix_w = (w_in[l], b_f[l], conv_w[l], g_conv_out[l], g_attn_out[l], w_out[l])
        conv0 = jnp.zeros((Bp, CONV_WIDTH - 1, D_CONV), xp.dtype)
        k0 = jnp.zeros((Bp, 0, H_ATTN, HD_ATTN), xp.dtype)
        f0 = jnp.zeros((Bp, 0, H_ATTN), jnp.float32)
        y, conv_p, k_p, v_p, f_p = parallel_mixer(rmsnorm(xp, g_mix[l]), conv0, k0, k0, f0, *mix_w)
        xp = xp + y
        mk_p, mv_p = memory_kv(mem_prompt, g_mem[l], w_xkv[l])
        xp = xp + cross_attention(rmsnorm(xp, g_xattn[l]), mk_p, mv_p, w_xq[l], w_xo[l])
        xp = xp + sq_relu_mlp(rmsnorm(xp, g_mlp[l]), w_up[l], w_down[l])
        y, conv_s, k_s, v_s, f_s = parallel_mixer(rmsnorm(xs, g_mix[l]), cache_conv[l], cache_k[l], cache_v[l],
                                                  cache_logf[l], *mix_w)
        xs = xs + y
        xs = xs + cross_attention(rmsnorm(xs, g_xattn[l]), cache_mem_k[l], cache_mem_v[l], w_xq[l], w_xo[l])
        xs = xs + sq_relu_mlp(rmsnorm(xs, g_mlp[l]), w_up[l], w_down[l])
        kp_l.append(k_p); vp_l.append(v_p); fp_l.append(f_p); cp_l.append(conv_p)
        mkp_l.append(mk_p); mvp_l.append(mv_p)
        ks_l.append(k_s); vs_l.append(v_s); fs_l.append(f_s); cs_l.append(conv_s)
    y_prompt = rmsnorm(xp, g_final)
    y_sample = rmsnorm(xs, g_final)
    new_k_prompt = jnp.stack(kp_l)
    new_v_prompt = jnp.stack(vp_l)
    new_logf_prompt = jnp.stack(fp_l)
    new_conv_prompt = jnp.stack(cp_l)
    new_mem_k_prompt = jnp.stack(mkp_l)
    new_mem_v_prompt = jnp.stack(mvp_l)
    new_k_sample = jnp.stack(ks_l)
    new_v_sample = jnp.stack(vs_l)
    new_logf_sample = jnp.stack(fs_l)
    new_conv_sample = jnp.stack(cs_l)
    return (y_prompt, y_sample, new_k_prompt, new_v_prompt, new_logf_prompt, new_conv_prompt,
            new_mem_k_prompt, new_mem_v_prompt, new_k_sample, new_v_sample, new_logf_sample, new_conv_sample)
```

```cpp
#include <hip/hip_runtime.h>
#include <hip/hip_bf16.h>
#include <cstdio>
#include <cstdint>

#define LAS __attribute__((address_space(3)))
#define GAS __attribute__((address_space(1)))
typedef unsigned short bf16_t;
typedef short bf16x8 __attribute__((ext_vector_type(8)));
typedef short s16x4 __attribute__((ext_vector_type(4)));
typedef float f32x2 __attribute__((ext_vector_type(2)));
typedef float f32x4 __attribute__((ext_vector_type(4)));
typedef float f32x16 __attribute__((ext_vector_type(16)));
typedef unsigned u32x2 __attribute__((ext_vector_type(2)));
typedef unsigned u32x4 __attribute__((ext_vector_type(4)));

constexpr int DM = 2048, NB_P = 2, SEQ = 4096, NB_S = 32, DSEQ = 32, PAST = 2048;
constexpr int DCONV = 1024, NH = 8, HD = 128, DATT = 1024, DIN = 6152, NMEM = 256, HX = 4, DX = 512, DFF = 8192;
constexpr int MP = NB_P * SEQ, MS = NB_S * DSEQ, MT = MP + MS;
constexpr int NIN = 6144;
constexpr float RMS_EPS = 1e-6f;
constexpr float LOG2E = 1.4426950408889634f;
constexpr float ATT_SCALE = 0.08838834764831845f;
constexpr int SKEYS = PAST + DSEQ;

constexpr size_t O_YP = 0, O_YS = O_YP + (size_t)MP * DM, O_KP = O_YS + (size_t)MS * DM, O_VP = O_KP + (size_t)MP * DATT, O_FP = O_VP + (size_t)MP * DATT,
                 O_CP = O_FP + (size_t)MP * NH, O_MKP = O_CP + (size_t)NB_P * 2 * DCONV, O_MVP = O_MKP + (size_t)NB_P * NMEM * DX, O_KS = O_MVP + (size_t)NB_P * NMEM * DX,
                 O_VS = O_KS + (size_t)MS * DATT, O_FS = O_VS + (size_t)MS * DATT, O_CS = O_FS + (size_t)MS * NH, O_END = O_CS + (size_t)NB_S * 2 * DCONV;

constexpr size_t MiB = 1u << 20;
constexpr size_t WS_CTL = 0, CTL_ZERO_BYTES = 64 * 1024;
constexpr size_t WS_WIN = 2 * MiB;
constexpr size_t WS_WOUT = WS_WIN + 26 * MiB;
constexpr size_t WS_WOUTR = WS_WOUT + 10 * MiB;
constexpr size_t WS_WXQ = WS_WOUTR + 8 * MiB;
constexpr size_t WS_WXKV = WS_WXQ + 2 * MiB;
constexpr size_t WS_WXO = WS_WXKV + 4 * MiB;
constexpr size_t WS_WUP = WS_WXO + 2 * MiB;
constexpr size_t WS_WDN = WS_WUP + 32 * MiB;
constexpr size_t WS_XN = WS_WDN + 32 * MiB;
constexpr size_t WS_MEMN = WS_XN + 36 * MiB;
constexpr size_t WS_X1 = WS_MEMN + 2 * MiB;
constexpr size_t WS_LOGF = WS_X1 + 72 * MiB;
constexpr size_t WS_BIASP = WS_LOGF + 1 * MiB;
constexpr size_t WS_BIASS = WS_BIASP + 1 * MiB;
constexpr size_t WS_SS = WS_BIASS + 3 * MiB;
constexpr size_t WS_MKP = WS_SS + 4 * MiB;
constexpr size_t WS_R0 = WS_MKP + 1 * MiB;
constexpr size_t WS_QPRE = WS_R0 + 1 * MiB;
constexpr size_t WS_ACT = WS_QPRE + 18 * MiB;
constexpr size_t WS_GB = WS_ACT;
constexpr size_t WS_U = WS_GB + 18 * MiB;
constexpr size_t WS_Q = WS_U + 18 * MiB;
constexpr size_t WS_K = WS_Q + 18 * MiB;
constexpr size_t WS_V = WS_K + 18 * MiB;
constexpr size_t WS_MIX = WS_V + 18 * MiB;
constexpr size_t WS_QX = WS_MIX + 36 * MiB;
constexpr size_t WS_OX = WS_QX + 9 * MiB;
constexpr size_t WS_H = WS_ACT;
constexpr size_t WS_PART = WS_ACT + 144 * MiB;
constexpr size_t WS_END = WS_PART + 64 * MiB;
static_assert(WS_OX + 9 * MiB <= WS_END, "activation overlay");

constexpr int CW_BAR = 4096;

constexpr int RING_BYTES = 131072;
constexpr int LDSCTL_OFF = RING_BYTES, MISC_OFF = LDSCTL_OFF + 320;
constexpr int SQA_ML_OFF = LDSCTL_OFF + 1024;
constexpr int SQA_FS_OFF = SQA_ML_OFF + 2048;
constexpr int SQA_Q_OFF = SQA_FS_OFF + 2048;
static_assert(SQA_Q_OFF + 8192 <= 147456, "LDS map");
constexpr int LDS_BYTES = 147456;
constexpr int NWAVES = 8;

#define LDS_WAIT() asm volatile("s_waitcnt lgkmcnt(0)" ::: "memory")
#define VM_WAIT() asm volatile("s_waitcnt vmcnt(0)" ::: "memory")
#define SBAR() __builtin_amdgcn_sched_barrier(0)

__device__ __forceinline__ unsigned cvt_pk_bf16(float lo, float hi) { unsigned r; asm volatile("v_cvt_pk_bf16_f32 %0, %1, %2" : "=v"(r) : "v"(lo), "v"(hi)); return r; }
__device__ __forceinline__ float bf2f(unsigned short b) { return __uint_as_float(((unsigned)b) << 16); }
__device__ __forceinline__ float wave_sum(float v) {
#pragma unroll
    for (int o = 1; o < 64; o <<= 1) v += __shfl_xor(v, o);
    return v;
}

namespace pg8 {
constexpr int BM = 256, BK = 64, HALF = 128, HTB = HALF * BK * 2, STAGE_BYTES = 8 * HTB, NXCD = 8, WGM = 8;
__host__ __device__ __forceinline__ int lds_byte(int r, int c) { const int st = (r >> 4) * 2 + (c >> 5), rr = r & 15, cc = c & 31, ob = rr * 64 + cc * 2; return st * 1024 + (ob ^ (((ob >> 9) & 1) << 5)); }
__host__ __device__ __forceinline__ void stage_rc(int b, int& R, int& C) { const int st = b / 1024, sb = b % 1024, swz = sb ^ (((sb >> 9) & 1) << 5); R = (st >> 1) * 16 + swz / 64; C = (st & 1) * 32 + (swz % 64) / 2; }
__host__ __device__ __forceinline__ int perm32(int rho) { const int n = rho >> 4, i = rho & 15; return 8 * (i >> 2) + 4 * n + (i & 3); }

struct Unit { int pm, pn, k0; };
struct Gemm { const bf16_t* A; const bf16_t* Bt; int ld, K; };

struct StaticOrder {
    int nM, nN, nwg, G, c;
    __host__ __device__ void init(int M, int N, int G_, int c_) { nM = M / BM; nN = N / BM; nwg = nM * nN; G = G_; c = c_; }
    __host__ __device__ bool next(int i, Unit& u) const {
        const long L = (long)i * G + c; if (L >= nwg) return false;
        int wgid = (int)L; { const int q = nwg / NXCD, r = nwg % NXCD, xcd = wgid % NXCD, off = wgid / NXCD; wgid = (xcd < r ? xcd * (q + 1) : r * (q + 1) + (xcd - r) * q) + off; }
        const int nig = WGM * nN, gid = wgid / nig, fm = gid * WGM, gsz = (nM - fm) < WGM ? (nM - fm) : WGM;
        u.pm = fm + ((wgid % nig) % gsz); u.pn = (wgid % nig) / gsz; u.k0 = 0; return true;
    }
};
struct SplitOrder {
    int pm0, nN, nu, ns, klen, G, c;
    __host__ __device__ bool next(int i, Unit& u) const { const int L = i * G + c; if (L >= nu * ns) return false; const int un = L / ns, sl = L % ns; u.pm = pm0 + un / nN; u.pn = un % nN; u.k0 = sl * klen; return true; }
};
struct TailOrder {
    int nN, nunits, G, c, skip;
    __host__ __device__ bool next(int i, Unit& u) const { const int j = c - (G - skip - nunits); if (i != 0 || j < 0 || j >= nunits) return false; u.pm = j / nN; u.pn = j % nN; u.k0 = 0; return true; }
};

template <class Epi, class Sched>
__device__ __forceinline__ void gemm_phase(LAS unsigned char* lds, const Gemm g, const Sched& S, const Epi& E) {
    const int tid = threadIdx.x, wid = __builtin_amdgcn_readfirstlane(tid >> 6), lane = tid & 63, wr = wid >> 2, wc = wid & 3, fr = lane & 15, fq = lane >> 4;
    const int K = g.K, nt = K / BK, ld = g.ld;
    unsigned voffA[2], voffB[2];
#pragma unroll
    for (int i = 0; i < 2; ++i) { int R, C; stage_rc(tid * 16 + i * 8192, R, C); const int Rb = (R & ~31) + perm32(R & 31);
        voffA[i] = (unsigned)(R * ld + C) * 2u; voffB[i] = (unsigned)(Rb * ld + C) * 2u; }
    const size_t kstep = (size_t)(BK * 2);
    const size_t hstep = (size_t)HALF * ld * 2;
    const size_t tstep = 2 * hstep;
    const unsigned ldsw = (unsigned)wid * 1024u;
    const int aoff = lds_byte(wr * 64 + fr, fq * 8), boff = lds_byte(wc * 32 + fr, fq * 8);
#define PG8_SA(b, h) (((b) * 2 + (h)) * HTB)
#define PG8_SB(b, h) ((4 + (b) * 2 + (h)) * HTB)
#define PG8_STAGE(bufoff, gbase, voff) do { _Pragma("unroll") for (int _i = 0; _i < 2; ++_i) \
        __builtin_amdgcn_global_load_lds((const unsigned*)((const char*)(gbase) + (voff)[_i]), (LAS unsigned*)(lds + (bufoff) + ldsw + _i * 8192), 16, 0, 0); } while (0)
#define PG8_LDA(dst, b, h) do { _Pragma("unroll") for (int m = 0; m < 4; ++m) _Pragma("unroll") for (int k = 0; k < 2; ++k) dst[m][k] = *(const LAS bf16x8*)(lds + PG8_SA(b, h) + aoff + m * 2048 + k * 1024); } while (0)
#define PG8_LDB(dst, b, h) do { _Pragma("unroll") for (int n = 0; n < 2; ++n) _Pragma("unroll") for (int k = 0; k < 2; ++k) dst[n][k] = *(const LAS bf16x8*)(lds + PG8_SB(b, h) + boff + n * 2048 + k * 1024); } while (0)
#define PG8_MMA(ai, bj, At, Bt) do { __builtin_amdgcn_s_setprio(1); _Pragma("unroll") for (int m = 0; m < 4; ++m) _Pragma("unroll") for (int n = 0; n < 2; ++n) _Pragma("unroll") for (int k = 0; k < 2; ++k) \
        acc[ai][bj][m][n] = __builtin_amdgcn_mfma_f32_16x16x32_bf16(Bt[n][k], At[m][k], acc[ai][bj][m][n], 0, 0, 0); __builtin_amdgcn_s_setprio(0); } while (0)
#define PG8_WAIT_V(n) asm volatile("s_waitcnt vmcnt(" #n ")" ::: "memory")
#define PG8_WAIT_L(n) asm volatile("s_waitcnt lgkmcnt(" #n ")" ::: "memory")
#define PG8_BAR __builtin_amdgcn_s_barrier()
#define PG8_SCHED __builtin_amdgcn_sched_barrier(0)
    Unit cur, nxt; int ui = 0;
    if (!S.next(0, cur)) return;
    f32x4 acc[2][2][4][2];
    bf16x8 At[4][2], B0[2][2], B1[2][2];
    const char* cA = (const char*)g.A + (size_t)cur.pm * tstep + (size_t)cur.k0 * 2; const char* cB = (const char*)g.Bt + (size_t)cur.pn * tstep + (size_t)cur.k0 * 2;
    PG8_STAGE(PG8_SB(0, 0), cB, voffB); PG8_STAGE(PG8_SB(0, 1), cB + hstep, voffB); PG8_STAGE(PG8_SA(0, 0), cA, voffA); PG8_STAGE(PG8_SA(0, 1), cA + hstep, voffA);
    E.init(acc, cur, wr, wc, fr, fq);
    if (wr == 1) PG8_BAR;
    PG8_WAIT_V(2); PG8_BAR;
    PG8_STAGE(PG8_SB(1, 0), cB + kstep, voffB); PG8_STAGE(PG8_SA(1, 0), cA + kstep, voffA); PG8_STAGE(PG8_SB(1, 1), cB + hstep + kstep, voffB);
    PG8_WAIT_V(6); PG8_BAR;
    for (;;) {
        const bool has_next = S.next(ui + 1, nxt);
        const char* nA = has_next ? (const char*)g.A + (size_t)nxt.pm * tstep + (size_t)nxt.k0 * 2 : cA; const char* nB = has_next ? (const char*)g.Bt + (size_t)nxt.pn * tstep + (size_t)nxt.k0 * 2 : cB;
        for (int t = 0; t < nt; t += 2) {
            const bool last = (t == nt - 2);
            const char* a1 = cA + (size_t)(t + 1) * kstep;
            const char* a2 = last ? nA : cA + (size_t)(t + 2) * kstep; const char* b2 = last ? nB : cB + (size_t)(t + 2) * kstep;
            const char* a3 = a2 + kstep; const char* b3 = b2 + kstep;
            PG8_LDB(B0, 0, 0); PG8_LDB(B1, 0, 1); PG8_SCHED; PG8_LDA(At, 0, 0); PG8_STAGE(PG8_SA(1, 1), a1 + hstep, voffA);
            PG8_WAIT_V(8); PG8_WAIT_L(0); PG8_BAR; PG8_MMA(0, 0, At, B0); PG8_MMA(0, 1, At, B1); PG8_BAR; PG8_SCHED;
            PG8_LDA(At, 0, 1); PG8_STAGE(PG8_SB(0, 0), b2, voffB); PG8_STAGE(PG8_SB(0, 1), b2 + hstep, voffB); PG8_STAGE(PG8_SA(0, 0), a2, voffA);
            PG8_WAIT_V(8); PG8_WAIT_L(0); PG8_BAR; PG8_MMA(1, 0, At, B0); PG8_MMA(1, 1, At, B1); PG8_BAR; PG8_SCHED;
            PG8_LDB(B0, 1, 0); PG8_LDB(B1, 1, 1); PG8_SCHED; PG8_LDA(At, 1, 0); PG8_STAGE(PG8_SA(0, 1), a2 + hstep, voffA);
            PG8_WAIT_V(8); PG8_WAIT_L(0); PG8_BAR; PG8_MMA(0, 0, At, B0); PG8_MMA(0, 1, At, B1); PG8_BAR; PG8_SCHED;
            PG8_LDA(At, 1, 1); PG8_STAGE(PG8_SB(1, 0), b3, voffB); PG8_STAGE(PG8_SB(1, 1), b3 + hstep, voffB); PG8_STAGE(PG8_SA(1, 0), a3, voffA);
            PG8_WAIT_V(8); PG8_WAIT_L(0); PG8_BAR; PG8_MMA(1, 0, At, B0); PG8_MMA(1, 1, At, B1); PG8_BAR; PG8_SCHED;
        }
        if (wr == 0) PG8_BAR;
        E(acc, cur, wr, wc, fr, fq);
        if (!has_next) break;
        E.init(acc, nxt, wr, wc, fr, fq);
        cur = nxt; cA = nA; cB = nB; ++ui;
        if (wr == 1) PG8_BAR;
    }
    PG8_WAIT_V(0);
    PG8_BAR;
#undef PG8_SA
#undef PG8_SB
#undef PG8_STAGE
#undef PG8_LDA
#undef PG8_LDB
#undef PG8_MMA
#undef PG8_WAIT_V
#undef PG8_WAIT_L
#undef PG8_BAR
#undef PG8_SCHED
}
}

__device__ __forceinline__ void acc_zero(f32x4 (&acc)[2][2][4][2]) {
#pragma unroll
    for (int a = 0; a < 2; ++a)
#pragma unroll
        for (int b = 0; b < 2; ++b)
#pragma unroll
            for (int m = 0; m < 4; ++m)
#pragma unroll
                for (int n = 0; n < 2; ++n) acc[a][b][m][n] = (f32x4){0.f, 0.f, 0.f, 0.f};
}
#define EPI_ZERO_INIT __device__ __forceinline__ void init(f32x4 (&acc)[2][2][4][2], const pg8::Unit&, int, int, int, int) const { acc_zero(acc); }
__device__ __forceinline__ u32x4 pack8(f32x4 a, f32x4 b) { u32x4 w; w.x = cvt_pk_bf16(a[0], a[1]); w.y = cvt_pk_bf16(a[2], a[3]); w.z = cvt_pk_bf16(b[0], b[1]); w.w = cvt_pk_bf16(b[2], b[3]); return w; }

__device__ __forceinline__ void store16_wt(void* p, u32x4 v) { asm volatile("global_store_dwordx4 %0, %1, off sc1\n\ts_nop 1" :: "v"(p), "v"(v) : "memory"); }
template <int NP> __device__ __forceinline__ float row_rstd(const float* SS, int row, int fq) {
    float s = 0.f;
#pragma unroll
    for (int p = 0; p < NP / 4; ++p) s += SS[(size_t)(fq * (NP / 4) + p) * MT + row];
    s += __shfl_xor(s, 16); s += __shfl_xor(s, 32);
    return __builtin_amdgcn_rsqf(s * (1.0f / DM) + RMS_EPS);
}

struct EpiWin {
    bf16_t *GB, *U, *Q, *K, *V; float* out; const float* R0; float* QPRE;
    EPI_ZERO_INIT
    __device__ __forceinline__ void operator()(const f32x4 (&acc)[2][2][4][2], const pg8::Unit& u, int wr, int wc, int fr, int fq) const {
        const int pn = u.pn, rowb = u.pm * 256 + wr * 64 + fr, cw = wc * 32 + 8 * fq;
        if (pn >= 24) {
            float irr[2][4];
#pragma unroll
            for (int ai = 0; ai < 2; ++ai)
#pragma unroll
                for (int m = 0; m < 4; ++m) irr[ai][m] = R0[rowb + ai * 128 + m * 16];
#pragma unroll
            for (int ai = 0; ai < 2; ++ai)
#pragma unroll
                for (int m = 0; m < 4; ++m) { const int row = rowb + ai * 128 + m * 16; const float ir = 1.0f / irr[ai][m];
#pragma unroll
                    for (int bj = 0; bj < 2; ++bj) { float* o = QPRE + (size_t)row * DX + (pn - 24) * 256 + bj * 128 + cw; *(f32x4*)o = acc[ai][bj][m][0] * ir; *(f32x4*)(o + 4) = acc[ai][bj][m][1] * ir; } }
            return;
        }
        if (pn >= 4 && pn < 12) {
            const int ch = (pn - 4) * 128 + cw;
#pragma unroll
            for (int ai = 0; ai < 2; ++ai)
#pragma unroll
                for (int m = 0; m < 4; ++m) { const int row = rowb + ai * 128 + m * 16;
                    const f32x4 u0 = acc[ai][0][m][0] * acc[ai][1][m][0], u1 = acc[ai][0][m][1] * acc[ai][1][m][1];
                    *(u32x4*)(U + (size_t)row * DCONV + ch) = pack8(u0, u1);
                    if (row < MP) { const int t = row & (SEQ - 1); if (t >= SEQ - 2) { float* o = out + O_CP + ((size_t)(row / SEQ) * 2 + (t - (SEQ - 2))) * DCONV + ch; *(f32x4*)o = u0; *(f32x4*)(o + 4) = u1; } }
                    else { const int rs = row - MP, t = rs & (DSEQ - 1); if (t >= DSEQ - 2) { float* o = out + O_CS + ((size_t)(rs / DSEQ) * 2 + (t - (DSEQ - 2))) * DCONV + ch; *(f32x4*)o = u0; *(f32x4*)(o + 4) = u1; } }
                }
            return;
        }
        bf16_t* dst; float* fo = nullptr; int ct;
        if (pn < 4) { dst = GB; ct = pn * 256; }
        else if (pn < 16) { dst = Q; ct = (pn - 12) * 256; }
        else if (pn < 20) { dst = K; ct = (pn - 16) * 256; }
        else { dst = V; ct = (pn - 20) * 256; }
#pragma unroll
        for (int ai = 0; ai < 2; ++ai)
#pragma unroll
            for (int m = 0; m < 4; ++m) { const int row = rowb + ai * 128 + m * 16;
#pragma unroll
                for (int bj = 0; bj < 2; ++bj) { const size_t off = (size_t)row * 1024 + ct + bj * 128 + cw;
                    *(u32x4*)(dst + off) = pack8(acc[ai][bj][m][0], acc[ai][bj][m][1]);
                    if (fo) { *(f32x4*)(fo + off) = acc[ai][bj][m][0]; *(f32x4*)(fo + off + 4) = acc[ai][bj][m][1]; } } }
    }
};
struct EpiMem {
    bf16_t* MK; float* out;
    EPI_ZERO_INIT
    __device__ __forceinline__ void operator()(const f32x4 (&acc)[2][2][4][2], const pg8::Unit& u, int wr, int wc, int fr, int fq) const {
        const int rowb = u.pm * 256 + wr * 64 + fr, isv = u.pn >> 1, ct = (u.pn & 1) * 256 + wc * 32 + 8 * fq;
        bf16_t* dst = MK + (size_t)isv * (512 * 512); float* fo = out + (isv ? O_MVP : O_MKP);
#pragma unroll
        for (int ai = 0; ai < 2; ++ai)
#pragma unroll
            for (int m = 0; m < 4; ++m) { const int row = rowb + ai * 128 + m * 16;
#pragma unroll
                for (int bj = 0; bj < 2; ++bj) { const size_t off = (size_t)row * DX + ct + bj * 128;
                    *(u32x4*)(dst + off) = pack8(acc[ai][bj][m][0], acc[ai][bj][m][1]);
                    *(f32x4*)(fo + off) = acc[ai][bj][m][0]; *(f32x4*)(fo + off + 4) = acc[ai][bj][m][1]; } }
    }
};
template <int MODE> struct EpiRes {
    const float* baseP; const float* baseS;
    bf16_t* xb; float* SS;
    const float* QPRE; bf16_t* QX;
    __device__ __forceinline__ void init(f32x4 (&acc)[2][2][4][2], const pg8::Unit& u, int wr, int wc, int fr, int fq) const {
        const int rowb = u.pm * 256 + wr * 64 + fr, ct = u.pn * 256 + wc * 32 + 8 * fq;
        if (MODE == 0 && u.pn >= 8) {
#pragma unroll
            for (int ai = 0; ai < 2; ++ai)
#pragma unroll
                for (int m = 0; m < 4; ++m)
#pragma unroll
                    for (int bj = 0; bj < 2; ++bj) { const size_t off = (size_t)(rowb + ai * 128 + m * 16) * DX + (ct - DM) + bj * 128; acc[ai][bj][m][0] = *(const f32x4*)(QPRE + off); acc[ai][bj][m][1] = *(const f32x4*)(QPRE + off + 4); }
            return;
        }
        const float* base = (u.pm < MP / 256) ? baseP : baseS - (size_t)MP * DM;
#pragma unroll
        for (int ai = 0; ai < 2; ++ai)
#pragma unroll
            for (int m = 0; m < 4; ++m)
#pragma unroll
                for (int bj = 0; bj < 2; ++bj) { const size_t off = (size_t)(rowb + ai * 128 + m * 16) * DM + ct + bj * 128;
                    if (MODE == 0) { acc[ai][bj][m][0] = *(const f32x4*)(base + off); acc[ai][bj][m][1] = *(const f32x4*)(base + off + 4); }
                    else { const u32x4 w = *(const u32x4*)(xb + off);
                        acc[ai][bj][m][0] = (f32x4){__uint_as_float(w.x << 16), __uint_as_float(w.x & 0xffff0000u), __uint_as_float(w.y << 16), __uint_as_float(w.y & 0xffff0000u)};
                        acc[ai][bj][m][1] = (f32x4){__uint_as_float(w.z << 16), __uint_as_float(w.z & 0xffff0000u), __uint_as_float(w.w << 16), __uint_as_float(w.w & 0xffff0000u)}; } }
    }
    __device__ __forceinline__ void operator()(const f32x4 (&acc)[2][2][4][2], const pg8::Unit& u, int wr, int wc, int fr, int fq) const {
        const int rowb = u.pm * 256 + wr * 64 + fr, ct = u.pn * 256 + wc * 32 + 8 * fq;
        if (MODE == 0 && u.pn >= 8) {
#pragma unroll
            for (int ai = 0; ai < 2; ++ai)
#pragma unroll
                for (int m = 0; m < 4; ++m)
#pragma unroll
                    for (int bj = 0; bj < 2; ++bj) *(u32x4*)(QX + (size_t)(rowb + ai * 128 + m * 16) * DX + (ct - DM) + bj * 128) = pack8(acc[ai][bj][m][0], acc[ai][bj][m][1]);
            return;
        }
#pragma unroll
        for (int ai = 0; ai < 2; ++ai)
#pragma unroll
            for (int m = 0; m < 4; ++m) { const int row = rowb + ai * 128 + m * 16; float s = 0.f;
#pragma unroll
                for (int bj = 0; bj < 2; ++bj) { const f32x4 v0 = acc[ai][bj][m][0], v1 = acc[ai][bj][m][1];
                    *(u32x4*)(xb + (size_t)row * DM + ct + bj * 128) = pack8(v0, v1);
                    s += (v0[0] * v0[0] + v0[1] * v0[1]) + (v0[2] * v0[2] + v0[3] * v0[3]) + (v1[0] * v1[0] + v1[1] * v1[1]) + (v1[2] * v1[2] + v1[3] * v1[3]); }
                s += __shfl_xor(s, 16); s += __shfl_xor(s, 32);
                if (fq == 0) SS[(size_t)(u.pn * 4 + wc) * MT + row] = s; }
    }
};
struct EpiPlain {
    bf16_t* O; int ldc;
    EPI_ZERO_INIT
    __device__ __forceinline__ void operator()(const f32x4 (&acc)[2][2][4][2], const pg8::Unit& u, int wr, int wc, int fr, int fq) const {
        const int rowb = u.pm * 256 + wr * 64 + fr, ct = u.pn * 256 + wc * 32 + 8 * fq;
#pragma unroll
        for (int ai = 0; ai < 2; ++ai)
#pragma unroll
            for (int m = 0; m < 4; ++m)
#pragma unroll
                for (int bj = 0; bj < 2; ++bj) *(u32x4*)(O + (size_t)(rowb + ai * 128 + m * 16) * ldc + ct + bj * 128) = pack8(acc[ai][bj][m][0], acc[ai][bj][m][1]);
    }
};
struct EpiPart {
    bf16_t* P; int row0, nrows, klen;
    EPI_ZERO_INIT
    __device__ __forceinline__ void operator()(const f32x4 (&acc)[2][2][4][2], const pg8::Unit& u, int wr, int wc, int fr, int fq) const {
        const int rowb = u.pm * 256 + wr * 64 + fr - row0, ct = u.pn * 256 + wc * 32 + 8 * fq;
        bf16_t* base = P + (size_t)(u.k0 / klen) * nrows * DM;
#pragma unroll
        for (int ai = 0; ai < 2; ++ai)
#pragma unroll
            for (int m = 0; m < 4; ++m) { const int row = rowb + ai * 128 + m * 16;
#pragma unroll
                for (int bj = 0; bj < 2; ++bj) *(u32x4*)(base + (size_t)row * DM + ct + bj * 128) = pack8(acc[ai][bj][m][0], acc[ai][bj][m][1]); }
    }
};
template <int ACT> struct EpiScale {
    bf16_t* O; int ldc; const float* SS;
    EPI_ZERO_INIT
    __device__ __forceinline__ void operator()(const f32x4 (&acc)[2][2][4][2], const pg8::Unit& u, int wr, int wc, int fr, int fq) const {
        const int rowb = u.pm * 256 + wr * 64 + fr, ct = u.pn * 256 + wc * 32 + 8 * fq;
        float rs[2][4];
#pragma unroll
        for (int ai = 0; ai < 2; ++ai)
#pragma unroll
            for (int m = 0; m < 4; ++m) rs[ai][m] = row_rstd<32>(SS, rowb + ai * 128 + m * 16, fq);
#pragma unroll
        for (int ai = 0; ai < 2; ++ai)
#pragma unroll
            for (int m = 0; m < 4; ++m) { const int row = rowb + ai * 128 + m * 16; const float r = rs[ai][m];
#pragma unroll
                for (int bj = 0; bj < 2; ++bj) { f32x4 v0 = acc[ai][bj][m][0] * r, v1 = acc[ai][bj][m][1] * r;
                    if (ACT == 1) {
#pragma unroll
                        for (int e = 0; e < 4; ++e) { const float a = fmaxf(v0[e], 0.f), b = fmaxf(v1[e], 0.f); v0[e] = a * a; v1[e] = b * b; } }
                    store16_wt(O + (size_t)row * ldc + ct + bj * 128, pack8(v0, v1)); } }
    }
};

typedef GAS unsigned gu32;
#define RLX_AGENT __ATOMIC_RELAXED, __HIP_MEMORY_SCOPE_AGENT
#define XB_TMO      128
#define XB_XCNT(j)  (256  + 64 * (j))
#define XB_XSUB(j)  (1280 + 64 * (j))
#define XB_XGEN(j)  (2304 + 64 * (j))
#define XB_TOP      3328
#define XB_TOPGEN   3392
#define XCD_BAR_WORDS 3456
#define XB_SPIN_CAP (1u << 18)
__device__ __forceinline__ unsigned xb_ld(unsigned* p)              { return __hip_atomic_load(p, __ATOMIC_RELAXED, __HIP_MEMORY_SCOPE_AGENT); }
__device__ __forceinline__ unsigned xb_add(unsigned* p, unsigned v) { return __hip_atomic_fetch_add(p, v, __ATOMIC_RELAXED, __HIP_MEMORY_SCOPE_AGENT); }
__device__ __forceinline__ unsigned xb_xcc_id() { return (unsigned)__builtin_amdgcn_s_getreg((3 << 11) | 20) & 0xFu; }
#define XB_SPIN(cond, bar) do { unsigned _sp = 0; while (cond) { __builtin_amdgcn_s_sleep(1); \
    if ((++_sp & 255u) == 0u) { if (xb_ld(&(bar)[XB_TMO])) break; if (_sp > XB_SPIN_CAP) { atomicAdd(&(bar)[XB_TMO], 1u); break; } } } } while (0)
struct XcdBarrier { unsigned* bar; unsigned x; volatile LAS unsigned* st; };
__device__ __forceinline__ XcdBarrier xcd_barrier_post(unsigned* bar, volatile LAS unsigned* st) {
    XcdBarrier b; b.bar = bar; b.x = xb_xcc_id(); b.st = st;
    if (threadIdx.x == 0) (void)xb_add(&bar[XB_XCNT(b.x)], 1u);
    return b;
}
__device__ __forceinline__ void xcd_barrier_complete(unsigned* bar, unsigned x, unsigned& nloc, unsigned& nx) {
    const unsigned G = gridDim.x * gridDim.y * gridDim.z;
    unsigned sum, cnt, mine, sp = 0u;
    for (;;) {
        sum = 0u; cnt = 0u; mine = 0u;
#pragma unroll
        for (unsigned j = 0; j < 16; ++j) { const unsigned c = xb_ld(&bar[XB_XCNT(j)]); sum += c; cnt += (c > 0u) ? 1u : 0u; mine = (j == x) ? c : mine; }
        if (sum == G) break;
        __builtin_amdgcn_s_sleep(1);
        if ((++sp & 255u) == 0u) { if (xb_ld(&bar[XB_TMO])) break; if (sp > XB_SPIN_CAP) { atomicAdd(&bar[XB_TMO], 1u); break; } }
    }
    nloc = mine > 0u ? mine : 1u; nx = cnt > 0u ? cnt : 1u;
}
__device__ __forceinline__ void xcd_barrier(const XcdBarrier& b) {
    asm volatile("s_waitcnt vmcnt(0)" ::: "memory");
    __syncthreads();
    if (threadIdx.x == 0) {
        unsigned* bar = b.bar;
        __builtin_amdgcn_s_waitcnt(0);
        unsigned nloc = b.st[0], nx = b.st[1];
        if (nloc == 0u) { xcd_barrier_complete(bar, b.x, nloc, nx); b.st[0] = nloc; b.st[1] = nx; }
        const unsigned old = xb_add(&bar[XB_XSUB(b.x)], 1u);
        const unsigned gen = old / nloc;
        if (old + 1u == (gen + 1u) * nloc) {
            __builtin_amdgcn_fence(__ATOMIC_RELEASE, "agent");
            asm volatile("s_waitcnt vmcnt(0)" ::: "memory");
            const unsigned og = xb_add(&bar[XB_TOP], 1u);
            const unsigned tg = og / nx;
            if (og + 1u == (tg + 1u) * nx) xb_add(&bar[XB_TOPGEN], 1u);
            else XB_SPIN(xb_ld(&bar[XB_TOPGEN]) == tg, bar);
            __builtin_amdgcn_fence(__ATOMIC_ACQUIRE, "agent");
            xb_add(&bar[XB_XGEN(b.x)], 1u);
            asm volatile("s_waitcnt vmcnt(0)" ::: "memory");
        } else {
            XB_SPIN(xb_ld(&bar[XB_XGEN(b.x)]) == gen, bar);
            __builtin_amdgcn_fence(__ATOMIC_ACQUIRE, "agent");
            asm volatile("s_waitcnt vmcnt(0)" ::: "memory");
        }
    }
    __syncthreads();
}

struct Args {
    const float* in[25];
    float* out; unsigned char* ws;
    int ph_lo, ph_hi;
};
enum { I_XP = 0, I_XS, I_CK, I_CV, I_CLF, I_CCONV, I_CMK, I_CMV, I_MEMP, I_GMIX, I_WIN, I_BF, I_CONVW, I_GCONV, I_GATTN, I_WOUT, I_GXATTN, I_GMEM, I_WXQ, I_WXKV, I_WXO, I_GMLP, I_WUP, I_WDN, I_GFINAL };

__device__ __forceinline__ unsigned f2bf(float f) { unsigned u = __builtin_bit_cast(unsigned, f); return (u + 0x7fffu + ((u >> 16) & 1u)) >> 16; }
__device__ __forceinline__ unsigned pk2(float lo, float hi) { return f2bf(lo) | (f2bf(hi) << 16); }
__device__ __forceinline__ void p0_transpose_item(const float* W, int K, int ldw, bf16_t* WT, int k0, int n0, int drow0, const float* gain, const float* gdiv, int lane) {
    const float* srcu = W + (size_t)k0 * ldw + n0;
    float v[64];
#pragma unroll
    for (int i = 0; i < 64; ++i) v[i] = srcu[(size_t)i * ldw + lane];
    if (gain) {
#pragma unroll
        for (int i = 0; i < 64; ++i) v[i] *= gain[k0 + i]; }
    if (gdiv) {
#pragma unroll
        for (int i = 0; i < 64; ++i) v[i] *= __builtin_amdgcn_rcpf(gdiv[k0 + i]); }
    bf16_t* dst = WT + (size_t)(drow0 + lane) * K + k0;
#pragma unroll
    for (int j = 0; j < 8; ++j) { u32x4 o; o.x = cvt_pk_bf16(v[8 * j], v[8 * j + 1]); o.y = cvt_pk_bf16(v[8 * j + 2], v[8 * j + 3]); o.z = cvt_pk_bf16(v[8 * j + 4], v[8 * j + 5]); o.w = cvt_pk_bf16(v[8 * j + 6], v[8 * j + 7]);
        *(u32x4*)(dst + 8 * j) = o; }
}
__device__ __forceinline__ int win_drow(int n0) {
    if (n0 < 1024 || n0 >= 3072) return n0;
    if (n0 < 2048) { const int c = n0 - 1024; return 1024 + 256 * (c >> 7) + (c & 127); }
    const int c = n0 - 2048; return 1024 + 256 * (c >> 7) + 128 + (c & 127);
}
__device__ __forceinline__ float log_sigmoidf(float a) { return fminf(a, 0.f) - log1pf(__expf(-fabsf(a))); }

__device__ __forceinline__ float block_excl_prefix(float T, LAS float* scr, int wave, int lane) {
    float v = T;
#pragma unroll
    for (int o = 1; o < 64; o <<= 1) { const float v2 = __shfl_up(v, o); if (lane >= o) v += v2; }
    __syncthreads();
    if (lane == 63) scr[wave] = v;
    __syncthreads();
    float off = 0.f;
#pragma unroll
    for (int w = 0; w < NWAVES; ++w) { const float t = scr[w]; if (w < wave) off += t; }
    return off + (v - T);
}

namespace att {
constexpr int NW = 8, QBLK = 32, KVBLK = 64, QB = NW * QBLK, D = 128;
constexpr int SHM_V = KVBLK * D * 2, SHM_K = KVBLK * D * 2;
constexpr int LDS_WS_OFF = 2 * SHM_V + 2 * SHM_K;
constexpr int LDS_BIAS_OFF = LDS_WS_OFF + NW * 64 * 4;
constexpr int LDS_TOTAL = LDS_BIAS_OFF + 4096 * 4;
constexpr float C2 = LOG2E * ATT_SCALE;
constexpr float THR2 = 16.f;
#define KSWZ(row, colB) ((row) * 256 + ((colB) ^ (((row) & 7) << 4)))
__device__ __forceinline__ int v_st(int k, int c) { const int kk = (k & ~0xC) | ((k & 4) << 1) | ((k & 8) >> 1); return ((kk >> 3) * 4 + (c >> 5)) * 512 + ((kk & 7) * 32 + (c & 31)) * 2; }
__device__ __forceinline__ int v_rd_base(int lane) { return ((lane & 3) << 3) | (((lane >> 2) & 3) << 6) | (((lane >> 4) & 1) << 5) | (((lane >> 5) & 1) << 8); }
constexpr int v_rd_off(int d0, int ks, int half) { return d0 * 512 + ks * 4096 + half * 2048; }
__device__ __forceinline__ int crow(int r, int hi) { return (r & 3) + 8 * (r >> 2) + 4 * hi; }
__device__ __forceinline__ bf16x8 load8(const bf16_t* p) { return *reinterpret_cast<const bf16x8*>(p); }
__device__ __forceinline__ void mask_tile(f32x16& p0, f32x16& p1, int dq) {
    const float NEG = -__builtin_inff();
#pragma unroll
    for (int r = 0; r < 16; ++r) { const int c = (r & 3) + 8 * (r >> 2); if (dq - c < 0) p0[r] = NEG; if (dq - c - 32 < 0) p1[r] = NEG; }
}
template <bool BIAS>
__device__ __forceinline__ void partialSM(f32x16& p0, f32x16& p1, float& m_reg, float& mn, float& alpha, const float* bl  , float c2) {
    if (BIAS) {
#pragma unroll
        for (int g = 0; g < 4; ++g) { const f32x4 b0 = *(const f32x4*)(bl + 8 * g), b1 = *(const f32x4*)(bl + 32 + 8 * g);
#pragma unroll
            for (int i = 0; i < 4; ++i) { p0[4 * g + i] = fmaf(p0[4 * g + i], c2, b0[i]); p1[4 * g + i] = fmaf(p1[4 * g + i], c2, b1[i]); } }
    } else {
#pragma unroll
        for (int r = 0; r < 16; ++r) { p0[r] *= c2; p1[r] *= c2; }
    }
    float pmax = p0[0];
#pragma unroll
    for (int r = 1; r < 16; ++r) pmax = fmaxf(pmax, p0[r]);
#pragma unroll
    for (int r = 0; r < 16; ++r) pmax = fmaxf(pmax, p1[r]);
    { auto rr = __builtin_amdgcn_permlane32_swap(__float_as_uint(pmax), __float_as_uint(pmax), false, false);
      pmax = fmaxf(__uint_as_float(rr[0]), __uint_as_float(rr[1])); }
    if (__builtin_expect(__all(pmax - m_reg <= THR2), 1)) { mn = m_reg; alpha = 1.f; }
    else { mn = fmaxf(m_reg, pmax); alpha = __builtin_amdgcn_exp2f(m_reg - mn); m_reg = mn; }
#pragma unroll
    for (int r = 0; r < 16; ++r) { p0[r] -= mn; p1[r] -= mn; }
#pragma unroll
    for (int r = 0; r < 16; ++r) p0[r] = __builtin_amdgcn_exp2f(p0[r]);
}
__device__ __forceinline__ void finishSM(f32x16& p0, f32x16& p1, float alpha, float& l_reg, bf16x8& pa0, bf16x8& pa1, bf16x8& pa2, bf16x8& pa3) {
#pragma unroll
    for (int r = 0; r < 16; ++r) p1[r] = __builtin_amdgcn_exp2f(p1[r]);
    float ps = 0;
#pragma unroll
    for (int r = 0; r < 16; ++r) ps += p0[r];
#pragma unroll
    for (int r = 0; r < 16; ++r) ps += p1[r];
    { auto rr = __builtin_amdgcn_permlane32_swap(__float_as_uint(ps), __float_as_uint(ps), false, false);
      ps = __uint_as_float(rr[0]) + __uint_as_float(rr[1]); }
    l_reg = l_reg * alpha + ps;
#define PK4(P, B_, OUT) do { unsigned a0 = cvt_pk_bf16(P[B_+0], P[B_+1]), a1 = cvt_pk_bf16(P[B_+2], P[B_+3]);                          \
        unsigned b0 = cvt_pk_bf16(P[B_+4], P[B_+5]), b1 = cvt_pk_bf16(P[B_+6], P[B_+7]);                                             \
        auto r0 = __builtin_amdgcn_permlane32_swap(a0, b0, false, false); auto r1 = __builtin_amdgcn_permlane32_swap(a1, b1, false, false); \
        u32x4 w = {r0[0], r1[0], r0[1], r1[1]}; OUT = *reinterpret_cast<bf16x8*>(&w); } while (0)
    PK4(p0, 0, pa0); PK4(p0, 8, pa1); PK4(p1, 0, pa2); PK4(p1, 8, pa3);
#undef PK4
}
template <int KB>
__device__ __forceinline__ void qkt(f32x16& p0, f32x16& p1, const char* K_lds, int r32, int hi, const bf16x8* qr) {
    p0 = f32x16{}; p1 = f32x16{};
    const char* kb[4];
#pragma unroll
    for (int dd = 0; dd < 4; ++dd) kb[dd] = K_lds + KB * SHM_K + KSWZ(r32, (dd * 16 + hi * 8) * 2);
#pragma unroll
    for (int d0 = 0; d0 < 8; ++d0) { const char* a = kb[d0 & 3] + (d0 >> 2) * 128;
        bf16x8 b0 = *reinterpret_cast<const bf16x8*>(a);
        bf16x8 b1 = *reinterpret_cast<const bf16x8*>(a + 32 * 256);
        p0 = __builtin_amdgcn_mfma_f32_32x32x16_bf16(b0, qr[d0], p0, 0, 0, 0);
        p1 = __builtin_amdgcn_mfma_f32_32x32x16_bf16(b1, qr[d0], p1, 0, 0, 0); }
}
template <int VB>
__device__ __forceinline__ void pv_tile(f32x16* o, int vb0, bf16x8 pa0, bf16x8 pa1, bf16x8 pa2, bf16x8 pa3) {
#define TRRD(dst, off) asm volatile("ds_read_b64_tr_b16 %0, %1 offset:%2" : "=&v"(dst) : "v"(vb0), "i"(off) : "memory")
#define PV_D0(d0) do { s16x4 l0, l1, l2, l3, h0, h1, h2, h3; constexpr int b_ = VB * SHM_V + v_rd_off(d0, 0, 0); \
        TRRD(l0, b_); TRRD(h0, b_ + 2048); TRRD(l1, b_ + 4096); TRRD(h1, b_ + 6144); TRRD(l2, b_ + 8192); TRRD(h2, b_ + 10240); TRRD(l3, b_ + 12288); TRRD(h3, b_ + 14336); \
        asm volatile("s_waitcnt lgkmcnt(0)" ::: "memory"); SBAR();   \
        o[d0] = __builtin_amdgcn_mfma_f32_32x32x16_bf16(pa0, (bf16x8){l0[0], l0[1], l0[2], l0[3], h0[0], h0[1], h0[2], h0[3]}, o[d0], 0, 0, 0);   \
        o[d0] = __builtin_amdgcn_mfma_f32_32x32x16_bf16(pa1, (bf16x8){l1[0], l1[1], l1[2], l1[3], h1[0], h1[1], h1[2], h1[3]}, o[d0], 0, 0, 0);   \
        o[d0] = __builtin_amdgcn_mfma_f32_32x32x16_bf16(pa2, (bf16x8){l2[0], l2[1], l2[2], l2[3], h2[0], h2[1], h2[2], h2[3]}, o[d0], 0, 0, 0);   \
        o[d0] = __builtin_amdgcn_mfma_f32_32x32x16_bf16(pa3, (bf16x8){l3[0], l3[1], l3[2], l3[3], h3[0], h3[1], h3[2], h3[3]}, o[d0], 0, 0, 0); } while (0)
    PV_D0(0); PV_D0(1); PV_D0(2); PV_D0(3);
#undef PV_D0
#undef TRRD
}
struct BlockRef { const bf16_t* Q; const bf16_t* K; const bf16_t* V; bf16_t* O; const float* bias; int P0; int skv; const float* SS; int row0; };
struct Seam { bf16x8 qr[8]; bf16x8 st_v0, st_v1, st_k0, st_k1; };
__device__ __forceinline__ int blk_jhi(const BlockRef& b) { int j = (b.P0 + QB - 1) / KVBLK + 1; if (j > b.skv / KVBLK) j = b.skv / KVBLK; return j; }
template <bool BIAS> __device__ __forceinline__ void load_bias(const BlockRef& b, char* lds) {
    if (BIAS) { const int nk = blk_jhi(b) * KVBLK; float* bl = (float*)(lds + LDS_BIAS_OFF);
        for (int i = threadIdx.x * 4; i < nk; i += 2048) *(f32x4*)(bl + i) = *(const f32x4*)(b.bias + i); }
}
#define ROW(p, S_, k0, rr) ((p) + (size_t)((k0) + (rr)) * (S_) + sc)
#define VMW() asm volatile("s_waitcnt vmcnt(0)" ::: "memory")
#define VMWN(n) asm volatile("s_waitcnt vmcnt(%0)" :: "i"(n) : "memory")
#define SLOAD_H(Kp, Vp, k0) do { S.st_v0 = load8(ROW(Vp, KS, k0, sr)); S.st_v1 = load8(ROW(Vp, KS, k0, 32 + sr));              \
                         S.st_k0 = load8(ROW(Kp, KS, k0, sr)); S.st_k1 = load8(ROW(Kp, KS, k0, 32 + sr)); } while (0)
#define SWRITE_HK(bf) do { *(bf16x8*)(K_lds + (bf) * SHM_K + kws) = S.st_k0; *(bf16x8*)(K_lds + (bf) * SHM_K + kws + 32 * 256) = S.st_k1; } while (0)
#define SWRITE_HV(bf) do { *(bf16x8*)(V_lds + (bf) * SHM_V + vst0) = S.st_v0; *(bf16x8*)(V_lds + (bf) * SHM_V + vst1) = S.st_v1; } while (0)
#define SWRITE_H(bf) do { SWRITE_HV(bf); SWRITE_HK(bf); } while (0)
template <int QS, int KS, bool BIAS>
__device__ __forceinline__ void attn_prime(const BlockRef& cur, char* lds, Seam& S) {
    const int tid = threadIdx.x, wid = __builtin_amdgcn_readfirstlane(tid >> 6), lane = tid & 63, r32 = lane & 31, hi = lane >> 5;
    const int sr = tid >> 4, sc = (tid & 15) * 8, kws = KSWZ(sr, sc * 2); char* K_lds = lds + 2 * SHM_V;
#pragma unroll
    for (int d0 = 0; d0 < 8; ++d0) S.qr[d0] = load8(cur.Q + (size_t)(wid * QBLK + r32) * QS + d0 * 16 + hi * 8);
    SLOAD_H(cur.K, cur.V, 0); VMW(); SWRITE_HK(0);
    load_bias<BIAS>(cur, lds);
    __syncthreads();
}
template <int QS, int KS, int OS, bool BIAS>
__device__ __forceinline__ void attn_block(const BlockRef& cur, const BlockRef& nxt, char* lds, Seam& S) {
    const int tid = threadIdx.x, wid = __builtin_amdgcn_readfirstlane(tid >> 6), lane = tid & 63, r32 = lane & 31, hi = lane >> 5;
    const int NT = blk_jhi(cur);
    const int qlo = cur.P0 + wid * QBLK, qm = qlo + r32 - 4 * hi;
    char* V_lds = lds; char* K_lds = lds + 2 * SHM_V;
    float* ws = (float*)(lds + LDS_WS_OFF) + wid * 64; float* li_l = ws, * al_l = ws + 32;
    const float* bias_l = (const float*)(lds + LDS_BIAS_OFF) + 4 * hi;
    float m_reg = -1e30f, l_reg = 0; f32x16 o[4] = {};
    float c2 = C2;
    if (cur.SS) { float s_ = 0.f; const int row_ = cur.row0 + wid * QBLK + r32;
#pragma unroll 8
        for (int p_ = 0; p_ < 32; ++p_) s_ += cur.SS[(size_t)p_ * MT + row_];
        c2 = C2 * __builtin_amdgcn_rsqf(s_ * (1.0f / DM) + RMS_EPS); }
    const int sr = tid >> 4, sc = (tid & 15) * 8, vst0 = v_st(sr, sc), vst1 = v_st(32 + sr, sc), kws = KSWZ(sr, sc * 2);
    const int vb0 = (int)(uintptr_t)V_lds + v_rd_base(lane);
    const bf16_t* Kh = cur.K; const bf16_t* Vh = cur.V;
#define RESC(a) do { if (__any((a) < 1.f)) { if (hi == 0) al_l[r32] = (a); asm volatile("s_waitcnt lgkmcnt(0)" ::: "memory");              \
                     for (int d_ = 0; d_ < 4; ++d_) for (int r = 0; r < 16; ++r) o[d_][r] *= al_l[crow(r, hi)]; } } while (0)
#define KBASE(t) ((t) * KVBLK)
#define MASKT(P0_, P1_, t) do { const int kb_ = KBASE(t); if (kb_ + KVBLK - 1 > qlo) mask_tile(P0_, P1_, qm - kb_); } while (0)
    constexpr int NQL = 8;
#define SEAM_K0() do { VMWN(NQL); SWRITE_HK(0); SBAR(); } while (0)
    f32x16 pA0, pA1, pB0, pB1; float mnA, mnB, alA, alB; bf16x8 pa0, pa1, pa2, pa3;
    SWRITE_HV(0); SBAR();
    if (NT > 1) { SLOAD_H(Kh, Vh, KBASE(1)); }
    SBAR(); qkt<0>(pA0, pA1, K_lds, r32, hi, S.qr);
    MASKT(pA0, pA1, 0); partialSM<BIAS>(pA0, pA1, m_reg, mnA, alA, bias_l + KBASE(0), c2);
    if (NT > 1) { VMW(); SWRITE_H(1); }
    __syncthreads();
#define HALF_STEP(PX0, PX1, mnX, alX, PY0, PY1, alY, t, KB, VB, SB) do {                                                      \
        SBAR(); qkt<KB>(PX0, PX1, K_lds, r32, hi, S.qr);                                             \
        finishSM(PY0, PY1, alY, l_reg, pa0, pa1, pa2, pa3); SBAR();                                                           \
        if ((t) + 1 < NT) { SLOAD_H(Kh, Vh, KBASE((t) + 1)); SBAR(); }                                               \
        pv_tile<VB>(o, vb0, pa0, pa1, pa2, pa3); MASKT(PX0, PX1, (t)); partialSM<BIAS>(PX0, PX1, m_reg, mnX, alX, bias_l + KBASE(t), c2);                                        \
        __syncthreads();                                                                                                      \
        if ((t) + 1 < NT) { VMW(); SWRITE_H(SB); }                                                                          \
        RESC(alX); __syncthreads(); } while (0)
    for (int t = 1; t + 1 < NT; t += 2) {
        HALF_STEP(pB0, pB1, mnB, alB, pA0, pA1, alA, t, 1, 0, 0);
        HALF_STEP(pA0, pA1, mnA, alA, pB0, pB1, alB, t + 1, 0, 1, 1);
    }
    const bool even = (NT & 1) == 0;
    if (even) { SBAR(); qkt<1>(pB0, pB1, K_lds, r32, hi, S.qr); SBAR(); }
    SLOAD_H(nxt.K, nxt.V, 0); SBAR();
#pragma unroll
    for (int d0 = 0; d0 < 8; ++d0) S.qr[d0] = load8(nxt.Q + (size_t)(wid * QBLK + r32) * QS + d0 * 16 + hi * 8);
    SBAR();
    finishSM(pA0, pA1, alA, l_reg, pa0, pa1, pa2, pa3); SBAR();
    pv_tile<0>(o, vb0, pa0, pa1, pa2, pa3);
    if (even) { MASKT(pB0, pB1, NT - 1); partialSM<BIAS>(pB0, pB1, m_reg, mnB, alB, bias_l + KBASE(NT - 1), c2); __syncthreads(); RESC(alB);
        finishSM(pB0, pB1, alB, l_reg, pa0, pa1, pa2, pa3); SBAR(); pv_tile<1>(o, vb0, pa0, pa1, pa2, pa3); }
    SBAR(); SEAM_K0();
    if (hi == 0) li_l[r32] = l_reg; asm volatile("s_waitcnt lgkmcnt(0)" ::: "memory");
    float rli[16];
#pragma unroll
    for (int r = 0; r < 16; ++r) rli[r] = __builtin_amdgcn_rcpf(li_l[crow(r, hi)]);
    bf16_t* Ow = cur.O + (size_t)(wid * QBLK) * OS;
#pragma unroll
    for (int r = 0; r < 16; ++r) { const int orow = crow(r, hi);
#pragma unroll
        for (int d0 = 0; d0 < 4; ++d0) { const float v = o[d0][r] * rli[r];
            const float vn = __shfl_xor(v, 1);
            if ((r32 & 1) == 0) *(unsigned*)(Ow + (size_t)orow * OS + d0 * 32 + r32) = cvt_pk_bf16(v, vn); } }
    load_bias<BIAS>(nxt, lds);
    __syncthreads();
#undef RESC
#undef KBASE
#undef MASKT
#undef SEAM_K0
#undef HALF_STEP
}
#undef ROW
#undef VMWN
#undef SLOAD_H
#undef SWRITE_HK
#undef SWRITE_HV
#undef SWRITE_H
}

namespace sqa {
using att::crow; using att::v_st; using att::v_rd_base; using att::v_rd_off; using att::C2;
template <bool BIAS, bool TAIL>
__device__ __forceinline__ void item(const bf16_t* Q, int QS, const float* Kc, const float* Vc, int CS, int KPW, const bf16_t* Kn, const bf16_t* Vn, int NS,
                                     const float* bias, bf16_t* O, int OS, char* lds, const float* SS, int row0) {
    int tid = threadIdx.x; asm volatile("" : "+v"(tid));
    const int wid = __builtin_amdgcn_readfirstlane(tid >> 6), lane = tid & 63, r32 = lane & 31, hi = lane >> 5;
    char* Kl = lds + wid * 16384; char* Vl = Kl + 8192;
    float* fs = (float*)(lds + SQA_FS_OFF) + wid * 64;
    float* MLm = (float*)(lds + SQA_ML_OFF); float* MLl = MLm + 256;
    char* Ql = lds + SQA_Q_OFF;
    { const int qrow = tid >> 4, qch = tid & 15; *(bf16x8*)(Ql + KSWZ(qrow, qch * 16)) = *(const bf16x8*)(Q + (size_t)qrow * QS + qch * 8); }
    __syncthreads();
    float m_reg = -1e30f, l_reg = 0.f; f32x16 o[4] = {};
    float c2 = C2;
    if (SS) { float s_ = 0.f;
#pragma unroll 8
        for (int p_ = 0; p_ < 32; ++p_) s_ += SS[(size_t)p_ * MT + row0 + r32];
        c2 = C2 * __builtin_amdgcn_rsqf(s_ * (1.0f / DM) + RMS_EPS); }
    const int vb0 = (int)(uintptr_t)Vl + v_rd_base(lane);
    const int lrow = lane >> 5, lcol = (lane & 31) * 4;
    const int kbeg = wid * KPW, nhalf = KPW / 16;
    const float* kp = Kc + (size_t)kbeg * CS; const float* vp = Vc + (size_t)kbeg * CS;
    const int loff = lrow * CS + lcol;
    int kwb[4];
#pragma unroll
    for (int j = 0; j < 4; ++j) kwb[j] = lrow * 256 + ((lcol * 2) ^ (lrow << 4) ^ (j << 5));
    const int vwb = (lcol >> 5) * 512 + lrow * 64 + (lcol & 31) * 2;
    f32x4 ks[8], vs[8];
#define SQA_LOADH(dst, base, hidx) do { _Pragma("unroll") for (int i_ = 0; i_ < 8; ++i_) dst[i_] = *(const f32x4*)((base) + (size_t)((hidx) * 16 + 2 * i_) * CS + loff); } while (0)
#define SQA_TRRD(dst, off) asm volatile("ds_read_b64_tr_b16 %0, %1 offset:%2" : "=&v"(dst) : "v"(vb0), "i"(off) : "memory")
#define SQA_TILE(bias_ptr, causal) do {                                                                                                   \
        f32x16 p = f32x16{};                                                                                                              \
        { int kb_[4]; _Pragma("unroll") for (int dd = 0; dd < 4; ++dd) kb_[dd] = KSWZ(r32, (dd * 16 + hi * 8) * 2);                         \
          _Pragma("unroll") for (int d0 = 0; d0 < 8; ++d0) { const bf16x8 a = *(const bf16x8*)(Kl + kb_[d0 & 3] + (d0 >> 2) * 128);       \
            const bf16x8 q_ = *(const bf16x8*)(Ql + kb_[d0 & 3] + (d0 >> 2) * 128);                                                        \
            p = __builtin_amdgcn_mfma_f32_32x32x16_bf16(a, q_, p, 0, 0, 0); } }                                                            \
        if (BIAS) { _Pragma("unroll") for (int g = 0; g < 4; ++g) { const f32x4 b = *(const f32x4*)((bias_ptr) + 4 * hi + 8 * g);         \
                _Pragma("unroll") for (int i = 0; i < 4; ++i) p[4 * g + i] = fmaf(p[4 * g + i], c2, b[i]); } }                              \
        else { _Pragma("unroll") for (int r = 0; r < 16; ++r) p[r] *= c2; }                                                                 \
        if (causal) { _Pragma("unroll") for (int r = 0; r < 16; ++r) if (crow(r, hi) > r32) p[r] = -__builtin_inff(); }                      \
        float pmax = p[0]; _Pragma("unroll") for (int r = 1; r < 16; ++r) pmax = fmaxf(pmax, p[r]);                                        \
        { auto rr = __builtin_amdgcn_permlane32_swap(__float_as_uint(pmax), __float_as_uint(pmax), false, false);                          \
          pmax = fmaxf(__uint_as_float(rr[0]), __uint_as_float(rr[1])); }                                                                  \
        const float mn = fmaxf(m_reg, pmax), alpha = __builtin_amdgcn_exp2f(m_reg - mn); m_reg = mn;                                      \
        float ps = 0.f; _Pragma("unroll") for (int r = 0; r < 16; ++r) { p[r] = __builtin_amdgcn_exp2f(p[r] - mn); ps += p[r]; }            \
        { auto rr = __builtin_amdgcn_permlane32_swap(__float_as_uint(ps), __float_as_uint(ps), false, false);                              \
          ps = __uint_as_float(rr[0]) + __uint_as_float(rr[1]); }                                                                          \
        l_reg = l_reg * alpha + ps;                                                                                                        \
        if (__any(alpha < 1.f)) { if (hi == 0) fs[r32] = alpha; LDS_WAIT();                                                                \
            _Pragma("unroll") for (int d_ = 0; d_ < 4; ++d_) _Pragma("unroll") for (int r = 0; r < 16; ++r) o[d_][r] *= fs[crow(r, hi)]; }     \
        bf16x8 pa0, pa1;                                                                                                                   \
        { unsigned a0 = cvt_pk_bf16(p[0], p[1]), a1 = cvt_pk_bf16(p[2], p[3]), b0 = cvt_pk_bf16(p[4], p[5]), b1 = cvt_pk_bf16(p[6], p[7]);     \
          auto r0 = __builtin_amdgcn_permlane32_swap(a0, b0, false, false); auto r1 = __builtin_amdgcn_permlane32_swap(a1, b1, false, false); \
          u32x4 w = {r0[0], r1[0], r0[1], r1[1]}; pa0 = *reinterpret_cast<bf16x8*>(&w); }                                                  \
        { unsigned a0 = cvt_pk_bf16(p[8], p[9]), a1 = cvt_pk_bf16(p[10], p[11]), b0 = cvt_pk_bf16(p[12], p[13]), b1 = cvt_pk_bf16(p[14], p[15]); \
          auto r0 = __builtin_amdgcn_permlane32_swap(a0, b0, false, false); auto r1 = __builtin_amdgcn_permlane32_swap(a1, b1, false, false); \
          u32x4 w = {r0[0], r1[0], r0[1], r1[1]}; pa1 = *reinterpret_cast<bf16x8*>(&w); }                                                  \
        _Pragma("unroll") for (int d0 = 0; d0 < 4; ++d0) { s16x4 l0, h0, l1, h1;                                                           \
            if (d0 == 0) { SQA_TRRD(l0, 0); SQA_TRRD(h0, 2048); SQA_TRRD(l1, 4096); SQA_TRRD(h1, 6144); }                                   \
            else if (d0 == 1) { SQA_TRRD(l0, 512); SQA_TRRD(h0, 2560); SQA_TRRD(l1, 4608); SQA_TRRD(h1, 6656); }                            \
            else if (d0 == 2) { SQA_TRRD(l0, 1024); SQA_TRRD(h0, 3072); SQA_TRRD(l1, 5120); SQA_TRRD(h1, 7168); }                           \
            else { SQA_TRRD(l0, 1536); SQA_TRRD(h0, 3584); SQA_TRRD(l1, 5632); SQA_TRRD(h1, 7680); }                                        \
            asm volatile("s_waitcnt lgkmcnt(0)" ::: "memory"); SBAR();                                                                    \
            o[d0] = __builtin_amdgcn_mfma_f32_32x32x16_bf16(pa0, (bf16x8){l0[0], l0[1], l0[2], l0[3], h0[0], h0[1], h0[2], h0[3]}, o[d0], 0, 0, 0); \
            o[d0] = __builtin_amdgcn_mfma_f32_32x32x16_bf16(pa1, (bf16x8){l1[0], l1[1], l1[2], l1[3], h1[0], h1[1], h1[2], h1[3]}, o[d0], 0, 0, 0); } \
        asm volatile("" ::: "memory");                                                                                                     \
    } while (0)
    SQA_LOADH(ks, kp, 0); SQA_LOADH(vs, vp, 0);
    for (int hh = 0; hh < nhalf; ++hh) {
        const int h = hh & 1; char* Kh_ = Kl + h * 4096; char* Vh_ = Vl + h * 4096 + vwb;
#pragma unroll
        for (int i = 0; i < 8; ++i) { u32x2 w; w.x = cvt_pk_bf16(ks[i][0], ks[i][1]); w.y = cvt_pk_bf16(ks[i][2], ks[i][3]);
            *(u32x2*)(Kh_ + kwb[i & 3] + (2 * i) * 256) = w; }
        if (hh + 1 < nhalf) SQA_LOADH(ks, kp, hh + 1);
#pragma unroll
        for (int i = 0; i < 8; ++i) { u32x2 w; w.x = cvt_pk_bf16(vs[i][0], vs[i][1]); w.y = cvt_pk_bf16(vs[i][2], vs[i][3]);
            *(u32x2*)(Vh_ + ((i >> 1) & 1) * 2048 + (i & 1) * 128 + (i >> 2) * 256) = w; }
        if (hh + 1 < nhalf) SQA_LOADH(vs, vp, hh + 1);
        if (h == 1) { asm volatile("" ::: "memory"); SQA_TILE(bias + kbeg + (hh >> 1) * 32, false); }
    }
    if (TAIL && wid == NWAVES - 1) {
        const int trow = lane >> 4, tc = (lane & 15) * 8;
        bf16x8 kn[8], vn[8];
#pragma unroll
        for (int i = 0; i < 8; ++i) { kn[i] = *(const bf16x8*)(Kn + (size_t)(4 * i + trow) * NS + tc); vn[i] = *(const bf16x8*)(Vn + (size_t)(4 * i + trow) * NS + tc); }
        const int tkb0 = trow * 256 + ((tc * 2) ^ (trow << 4)), tkb1 = trow * 256 + ((tc * 2) ^ (trow << 4) ^ 64);
        const int tvb = (tc >> 5) * 512 + trow * 64 + (tc & 31) * 2;
#pragma unroll
        for (int i = 0; i < 8; ++i) { *(bf16x8*)(Kl + ((i & 1) ? tkb1 : tkb0) + (4 * i) * 256) = kn[i]; *(bf16x8*)(Vl + tvb + (i & 1) * 2048 + (i >> 2) * 4096 + ((i >> 1) & 1) * 256) = vn[i]; }
        asm volatile("" ::: "memory");
        SQA_TILE(bias + NWAVES * KPW, true);
    }
    if (hi == 0) { MLm[wid * 32 + r32] = m_reg; MLl[wid * 32 + r32] = l_reg; }
    __syncthreads();
    { float M = -1e30f;
#pragma unroll
      for (int w = 0; w < NWAVES; ++w) M = fmaxf(M, MLm[w * 32 + r32]);
      float L = 0.f;
#pragma unroll
      for (int w = 0; w < NWAVES; ++w) L += MLl[w * 32 + r32] * __builtin_amdgcn_exp2f(MLm[w * 32 + r32] - M);
      const float f = __builtin_amdgcn_exp2f(m_reg - M) / L;
      if (hi == 0) fs[r32] = f; LDS_WAIT(); }
    { float* Op = (float*)(lds + wid * 16384);
#pragma unroll
      for (int d0 = 0; d0 < 4; ++d0)
#pragma unroll
          for (int r = 0; r < 16; ++r) Op[crow(r, hi) * 128 + d0 * 32 + r32] = o[d0][r] * fs[crow(r, hi)]; }
    __syncthreads();
    { const int row = tid >> 4, c8 = (tid & 15) * 8; f32x4 a0 = {0.f, 0.f, 0.f, 0.f}, a1 = {0.f, 0.f, 0.f, 0.f};
#pragma unroll
      for (int w = 0; w < NWAVES; ++w) { const float* s = (const float*)(lds + w * 16384) + row * 128 + c8; a0 += *(const f32x4*)s; a1 += *(const f32x4*)(s + 4); }
      *(u32x4*)(O + (size_t)row * OS + c8) = pack8(a0, a1); }
    __syncthreads();
#undef SQA_LOADH
#undef SQA_TRRD
#undef SQA_TILE
}
}
#undef KSWZ

#ifndef MK_N_LAUNCHES
#define MK_N_LAUNCHES 1
#endif
constexpr int N_PHASES = 11;
constexpr int N_LAUNCHES = MK_N_LAUNCHES;

__device__ __forceinline__ void load_row(const float* xrow, int lane, f32x4 (&v)[8]) {
    const f32x4* xr = (const f32x4*)xrow + lane;
#pragma unroll
    for (int j = 0; j < 8; ++j) v[j] = xr[64 * j];
}
__device__ __forceinline__ float norm_row(f32x4 (&v)[8], const f32x4 (&g)[8], bf16_t* orow, int lane) {
    float s = 0.f;
#pragma unroll
    for (int j = 0; j < 8; ++j) s += (v[j][0] * v[j][0] + v[j][1] * v[j][1]) + (v[j][2] * v[j][2] + v[j][3] * v[j][3]);
    const float r = __builtin_amdgcn_rsqf(wave_sum(s) * (1.0f / DM) + RMS_EPS);
    u32x2* o8 = (u32x2*)orow + lane;
#pragma unroll
    for (int j = 0; j < 8; ++j) { v[j] = v[j] * r * g[j]; u32x2 w; w.x = cvt_pk_bf16(v[j][0], v[j][1]); w.y = cvt_pk_bf16(v[j][2], v[j][3]); o8[64 * j] = w; }
    return r;
}

__global__ void __launch_bounds__(NWAVES * 64, 2) fox_fwd(Args args) {
    extern __shared__ __attribute__((aligned(16))) unsigned char lds[];
    const int tid = threadIdx.x, lane = tid & 63, wave = __builtin_amdgcn_readfirstlane(tid >> 6);
    const int G = gridDim.x; const int bx = blockIdx.x; const int vcu = (G % 8 == 0) ? (bx % 8) * (G / 8) + bx / 8 : bx;
    unsigned char* ws = args.ws; float* out = args.out;
    gu32* ctl = (gu32*)(ws + WS_CTL);
    volatile LAS unsigned* MISC = (volatile LAS unsigned*)((LAS unsigned char*)lds + MISC_OFF);
    for (int u = tid; u < (LDS_BYTES - LDSCTL_OFF) / 4; u += NWAVES * 64) ((LAS unsigned*)((LAS unsigned char*)lds + LDSCTL_OFF))[u] = 0u;
    __syncthreads();
    XcdBarrier bar; bar.bar = (unsigned*)(ctl + CW_BAR); bar.x = 0; bar.st = nullptr;
    if (N_LAUNCHES == 1) bar = xcd_barrier_post((unsigned*)(ctl + CW_BAR), MISC + 8);
    const int lo = args.ph_lo, hi_ph = args.ph_hi;
#ifndef PH_MASK
#define PH_MASK 0x7ff
#endif
#define IN(k) (((PH_MASK >> (k)) & 1) && lo <= (k) && (k) < hi_ph)
#define GRID_BAR(k) do { if (IN(k) && IN((k) + 1)) xcd_barrier(bar); } while (0)
    bf16_t* Win_t = (bf16_t*)(ws + WS_WIN); bf16_t* Wout_t = (bf16_t*)(ws + WS_WOUT); bf16_t* Wxq_t = (bf16_t*)(ws + WS_WXQ); bf16_t* Wxkv_t = (bf16_t*)(ws + WS_WXKV);
    bf16_t* Wxo_t = (bf16_t*)(ws + WS_WXO); bf16_t* Wup_t = (bf16_t*)(ws + WS_WUP); bf16_t* Wdn_t = (bf16_t*)(ws + WS_WDN);
    bf16_t* XN = (bf16_t*)(ws + WS_XN); bf16_t* MEMN = (bf16_t*)(ws + WS_MEMN); float* X1 = (float*)(ws + WS_X1); float* LOGF = (float*)(ws + WS_LOGF);
    float* BIASP = (float*)(ws + WS_BIASP); float* BIASS = (float*)(ws + WS_BIASS); float* SS1 = (float*)(ws + WS_SS); float* SS2 = SS1 + 32 * MT; float* SS3 = SS2 + 32 * MT;
    bf16_t* MKP = (bf16_t*)(ws + WS_MKP); bf16_t* GB = (bf16_t*)(ws + WS_GB); bf16_t* U = (bf16_t*)(ws + WS_U); bf16_t* QB = (bf16_t*)(ws + WS_Q); bf16_t* KB = (bf16_t*)(ws + WS_K);
    bf16_t* VB = (bf16_t*)(ws + WS_V); bf16_t* MIX = (bf16_t*)(ws + WS_MIX); bf16_t* QX = (bf16_t*)(ws + WS_QX); bf16_t* OX = (bf16_t*)(ws + WS_OX); bf16_t* HB = (bf16_t*)(ws + WS_H); bf16_t* PART = (bf16_t*)(ws + WS_PART); bf16_t* WoutR = (bf16_t*)(ws + WS_WOUTR); float* R0 = (float*)(ws + WS_R0); float* QPRE = (float*)(ws + WS_QPRE);
    const int gw = vcu * NWAVES + wave, NGW = G * NWAVES;
    LAS unsigned char* ldsl = (LAS unsigned char*)lds;

    if (IN(0)) {
        LAS float* wf = (LAS float*)(ldsl + 65536);
        { const float* W = args.in[I_WIN];
          for (int i0 = 0; i0 < 32; i0 += 8) { float t[8];
#pragma unroll
              for (int e = 0; e < 8; ++e) { const int idx = tid + (i0 + e) * (NWAVES * 64); t[e] = W[(size_t)(idx >> 3) * DIN + NIN + (idx & 7)]; }
#pragma unroll
              for (int e = 0; e < 8; ++e) { const int idx = tid + (i0 + e) * (NWAVES * 64); wf[(idx & 7) * DM + (idx >> 3)] = t[e]; } } }
        __syncthreads();
        f32x4 gmix[8]; load_row(args.in[I_GMIX], lane, gmix);
        const float bfl = args.in[I_BF][lane >> 3];
        f32x4 vn[8]; if (gw < MT) load_row((gw < MP) ? args.in[I_XP] + (size_t)gw * DM : args.in[I_XS] + (size_t)(gw - MP) * DM, lane, vn);
        for (int m = gw; m < MT; m += NGW) {
            f32x4 v[8];
#pragma unroll
            for (int j = 0; j < 8; ++j) v[j] = vn[j];
            { const int mn_ = m + NGW; if (mn_ < MT) load_row((mn_ < MP) ? args.in[I_XP] + (size_t)mn_ * DM : args.in[I_XS] + (size_t)(mn_ - MP) * DM, lane, vn); }
            const float r0 = norm_row(v, gmix, XN + (size_t)m * DM, lane); if (lane == 0) R0[m] = r0;
            float z[8];
#pragma unroll
            for (int h = 0; h < 8; ++h) { float a = 0.f;
#pragma unroll
                for (int j = 0; j < 8; ++j) { const f32x4 w = *(const LAS f32x4*)(wf + h * DM + 256 * j + 4 * lane); a += (v[j][0] * w[0] + v[j][1] * w[1]) + (v[j][2] * w[2] + v[j][3] * w[3]); }
                z[h] = a; }
            float zz;
            { const bool u5 = (lane & 32) != 0, u4 = (lane & 16) != 0, u3 = (lane & 8) != 0; float b4[4], b2[2];
#pragma unroll
              for (int i = 0; i < 4; ++i) { const float keep = u5 ? z[4 + i] : z[i], give = u5 ? z[i] : z[4 + i]; b4[i] = keep + __shfl_xor(give, 32); }
#pragma unroll
              for (int i = 0; i < 2; ++i) { const float keep = u4 ? b4[2 + i] : b4[i], give = u4 ? b4[i] : b4[2 + i]; b2[i] = keep + __shfl_xor(give, 16); }
              { const float keep = u3 ? b2[1] : b2[0], give = u3 ? b2[0] : b2[1]; zz = keep + __shfl_xor(give, 8); }
              zz += __shfl_xor(zz, 4); zz += __shfl_xor(zz, 2); zz += __shfl_xor(zz, 1); }
            if ((lane & 7) == 0) { const int hh_ = lane >> 3;
                const float lf = log_sigmoidf(zz + bfl);
                LOGF[(size_t)m * NH + hh_] = lf;
                if (m < MP) out[O_FP + (size_t)m * NH + hh_] = lf; else out[O_FS + (size_t)(m - MP) * NH + hh_] = lf; }
        }
        { f32x4 gmem[8]; load_row(args.in[I_GMEM], lane, gmem);
          for (int m = gw; m < NB_P * NMEM; m += NGW) { f32x4 v[8]; load_row(args.in[I_MEMP] + (size_t)m * DM, lane, v); (void)norm_row(v, gmem, MEMN + (size_t)m * DM, lane); } }
        for (int k = gw; k < DM; k += NGW) {
            const float g = (k < DCONV) ? args.in[I_GCONV][k] : args.in[I_GATTN][k - DCONV];
            f32x4 w8[8]; load_row(args.in[I_WOUT] + (size_t)k * DM, lane, w8); u32x2* o8 = (u32x2*)(WoutR + (size_t)k * DM) + lane;
#pragma unroll
            for (int j = 0; j < 8; ++j) { const f32x4 w = w8[j] * g; u32x2 o; o.x = cvt_pk_bf16(w[0], w[1]); o.y = cvt_pk_bf16(w[2], w[3]); o8[64 * j] = o; }
        }
        constexpr int I_IN = (DM / 64) * (NIN / 64), I_XQ = (DM / 64) * (DX / 64), I_XKV = (DM / 64) * (2 * DX / 64),
                      NITEMS = I_IN + 2 * I_XQ + I_XKV;
        for (int it = gw; it < NITEMS; it += NGW) {
            int r = it;
            if (r < I_IN) { const int nb = NIN / 64, kb = r / nb, n0 = (r % nb) * 64; p0_transpose_item(args.in[I_WIN], DM, DIN, Win_t, kb * 64, n0, win_drow(n0), nullptr, nullptr, lane); continue; } r -= I_IN;
            if (r < I_XQ) { const int nb = DX / 64, kb = r / nb, n0 = (r % nb) * 64; p0_transpose_item(args.in[I_WXQ], DM, DX, Wxq_t, kb * 64, n0, n0, args.in[I_GXATTN], nullptr, lane); continue; } r -= I_XQ;
            if (r < I_XQ) { const int nb = DX / 64, kb = r / nb, n0 = (r % nb) * 64; p0_transpose_item(args.in[I_WXQ], DM, DX, Win_t, kb * 64, n0, NIN + n0, args.in[I_GXATTN], args.in[I_GMIX], lane); continue; } r -= I_XQ;
            { const int nb = 2 * DX / 64, kb = r / nb, n0 = (r % nb) * 64; p0_transpose_item(args.in[I_WXKV], DM, 2 * DX, Wxkv_t, kb * 64, n0, n0, nullptr, nullptr, lane); }
        }
        __syncthreads();
    }
    GRID_BAR(0);

    if (IN(1)) {
        { pg8::Gemm g{XN, Win_t, DM, DM}; pg8::StaticOrder S; S.init(MT, NIN + DX, G, bx);
          EpiWin E{GB, U, QB, KB, VB, out, R0, QPRE};
          pg8::gemm_phase(ldsl, g, S, E); }
        { pg8::Gemm g{Wxq_t, WoutR, DM, DM}; pg8::TailOrder S{8, 16, G, bx, 8};
          EpiPlain E{Wout_t + (size_t)DM * DM, DM};
          pg8::gemm_phase(ldsl, g, S, E); }
        { pg8::Gemm g{MEMN, Wxkv_t, DM, DM}; pg8::TailOrder S{4, 8, G, bx, 0};
          EpiMem E{MKP, out};
          pg8::gemm_phase(ldsl, g, S, E); }
        { LAS float* scr = (LAS float*)ldsl;
          int s0 = ((MT / 256) * ((NIN + DX) / 256)) % G, s1 = G - 24; if (s1 - s0 < 8) { s0 = 0; s1 = G; }
          const int ns = s1 - s0;
          if (bx >= s0 && bx < s1) { constexpr int I_OUT = (DM / 64) * (DM / 64), I_XO = (DX / 64) * (DM / 64);
              for (int it = (bx - s0) * NWAVES + wave; it < I_OUT + I_XO; it += ns * NWAVES) {
                  if (it < I_OUT) { const int nb = DM / 64, kb = it / nb, n0 = (it % nb) * 64; const float* g = (kb * 64 < DCONV) ? args.in[I_GCONV] : args.in[I_GATTN] - DCONV;
                      p0_transpose_item(args.in[I_WOUT], DM, DM, Wout_t, kb * 64, n0, n0, g, nullptr, lane); }
                  else { const int r = it - I_OUT, nb = DM / 64, kb = r / nb, n0 = (r % nb) * 64; p0_transpose_item(args.in[I_WXO], DX, DM, Wxo_t, kb * 64, n0, n0, nullptr, nullptr, lane); } } }
          if (bx >= s0 && bx < s1) for (int it = bx - s0; it < NB_S * NH + NB_P * NH; it += ns) {
            if (it < NB_S * NH) {
                const int b = it >> 3, h = it & 7; const float* lf = args.in[I_CLF] + (size_t)b * PAST * NH + h; float* bo = BIASS + (size_t)it * SKEYS;
                float v[4]; float T = 0.f;
#pragma unroll
                for (int e = 0; e < 4; ++e) { const int jp = 4 * tid + e; v[e] = lf[(size_t)(PAST - 1 - jp) * NH]; T += v[e]; }
                float run = block_excl_prefix(T, scr, wave, lane);
#pragma unroll
                for (int e = 0; e < 4; ++e) { const int jp = 4 * tid + e; bo[PAST - 1 - jp] = LOG2E * run; run += v[e]; }
                if (tid < 64) { const int i = lane & 31; float x = LOGF[(size_t)(MP + b * DSEQ + i) * NH + h];
#pragma unroll
                    for (int o = 1; o < 32; o <<= 1) { const float x2 = __shfl_up(x, o); if (i >= o) x += x2; }
                    if (lane < 32) bo[PAST + i] = -LOG2E * x; }
            } else {
                const int ip = it - NB_S * NH, b = ip >> 3, h = ip & 7; const float* lf = LOGF + (size_t)b * SEQ * NH + h; float* bo = BIASP + (size_t)ip * SEQ;
                float v[8]; float T = 0.f;
#pragma unroll
                for (int e = 0; e < 8; ++e) { v[e] = lf[(size_t)(8 * tid + e) * NH]; T += v[e]; }
                float run = block_excl_prefix(T, scr, wave, lane);
#pragma unroll
                for (int e = 0; e < 8; ++e) { run += v[e]; bo[8 * tid + e] = -LOG2E * run; }
            }
          }
        }
    }
    GRID_BAR(1);

    if (IN(2)) {
        for (int it = vcu; it < 256; it += G) {
            if (it < 128) {
#ifndef DBG_NO_ATT
                const int bh = it >> 3, x = it & 7, b = bh >> 3, h = bh & 7;
                const size_t hb = (size_t)b * SEQ * DATT + h * HD;
                att::BlockRef r0{QB + hb + (size_t)x * 256 * DATT, KB + hb, VB + hb, MIX + (size_t)b * SEQ * DM + DCONV + h * HD + (size_t)x * 256 * DM, BIASP + (size_t)bh * SEQ, x * 256, SEQ, nullptr, 0};
                att::BlockRef r1 = r0; const int y = 15 - x; r1.Q = QB + hb + (size_t)y * 256 * DATT; r1.O = MIX + (size_t)b * SEQ * DM + DCONV + h * HD + (size_t)y * 256 * DM; r1.P0 = y * 256;
                att::Seam S;
                att::attn_prime<DATT, DATT, true>(r0, (char*)lds, S);
                att::attn_block<DATT, DATT, DM, true>(r0, r1, (char*)lds, S);
                att::attn_block<DATT, DATT, DM, true>(r1, r1, (char*)lds, S);
                VM_WAIT(); __syncthreads();
#endif
            } else {
#ifndef DBG_NO_SQA
                for (int k = 0; k < 2; ++k) { const int sh = (it - 128) * 2 + k, b = sh >> 3, h = sh & 7;
                    const size_t row0 = (size_t)(MP + b * DSEQ);
                    sqa::item<true, true>(QB + row0 * DATT + h * HD, DATT, args.in[I_CK] + (size_t)b * PAST * DATT + h * HD, args.in[I_CV] + (size_t)b * PAST * DATT + h * HD, DATT, PAST / NWAVES,
                                          KB + row0 * DATT + h * HD, VB + row0 * DATT + h * HD, DATT, BIASS + (size_t)sh * SKEYS, MIX + row0 * DM + DCONV + h * HD, DM, (char*)lds, nullptr, 0); }
#endif
            }
        }
        { const int c0 = G >= 256 ? 128 : 0, nc = G - c0;
          if (vcu >= c0) {
            const float* cw = args.in[I_CONVW];
            float w0[16], w1[16], w2[16];
#pragma unroll
            for (int e = 0; e < 16; ++e) { w0[e] = cw[16 * lane + e]; w1[e] = cw[DCONV + 16 * lane + e]; w2[e] = cw[2 * DCONV + 16 * lane + e]; }
            for (int m = (vcu - c0) * NWAVES + wave; m < MT; m += nc * NWAVES) {
                int t, b; bool smp = m >= MP; if (!smp) { b = m / SEQ; t = m % SEQ; } else { b = (m - MP) / DSEQ; t = (m - MP) % DSEQ; }
                float um[16], u1[16], u2[16], gbv[16];
                { const bf16x8* p = (const bf16x8*)(U + (size_t)m * DCONV + 16 * lane); const bf16x8 a = p[0], c = p[1];
#pragma unroll
                  for (int e = 0; e < 8; ++e) { um[e] = bf2f((unsigned short)a[e]); um[8 + e] = bf2f((unsigned short)c[e]); }
                  const bf16x8* q = (const bf16x8*)(GB + (size_t)m * DCONV + 16 * lane); const bf16x8 ga = q[0], gc = q[1];
#pragma unroll
                  for (int e = 0; e < 8; ++e) { gbv[e] = bf2f((unsigned short)ga[e]); gbv[8 + e] = bf2f((unsigned short)gc[e]); } }
#define CONV_PREV(dst, back) do { if (t >= (back)) { const bf16x8* p = (const bf16x8*)(U + (size_t)(m - (back)) * DCONV + 16 * lane); const bf16x8 a = p[0], c = p[1];           \
                _Pragma("unroll") for (int e = 0; e < 8; ++e) { dst[e] = bf2f((unsigned short)a[e]); dst[8 + e] = bf2f((unsigned short)c[e]); } }                                \
            else if (smp) { const float* p = args.in[I_CCONV] + ((size_t)b * 2 + (2 + t - (back))) * DCONV + 16 * lane; _Pragma("unroll") for (int e = 0; e < 16; ++e) dst[e] = p[e]; } \
            else { _Pragma("unroll") for (int e = 0; e < 16; ++e) dst[e] = 0.f; } } while (0)
                CONV_PREV(u1, 1); CONV_PREV(u2, 2);
#undef CONV_PREV
                float yc[16]; float s = 0.f;
#pragma unroll
                for (int e = 0; e < 16; ++e) { yc[e] = gbv[e] * (w0[e] * u2[e] + w1[e] * u1[e] + w2[e] * um[e]); s += yc[e] * yc[e]; }
                const float rc = __builtin_amdgcn_rsqf(wave_sum(s) * (1.0f / DCONV) + RMS_EPS);
                u32x4 o0, o1;
                o0.x = cvt_pk_bf16(yc[0] * rc, yc[1] * rc); o0.y = cvt_pk_bf16(yc[2] * rc, yc[3] * rc); o0.z = cvt_pk_bf16(yc[4] * rc, yc[5] * rc); o0.w = cvt_pk_bf16(yc[6] * rc, yc[7] * rc);
                o1.x = cvt_pk_bf16(yc[8] * rc, yc[9] * rc); o1.y = cvt_pk_bf16(yc[10] * rc, yc[11] * rc); o1.z = cvt_pk_bf16(yc[12] * rc, yc[13] * rc); o1.w = cvt_pk_bf16(yc[14] * rc, yc[15] * rc);
                u32x4* mo = (u32x4*)(MIX + (size_t)m * DM + 16 * lane); mo[0] = o0; mo[1] = o1;
            } } }
        { const int c0 = G >= 256 ? 128 : 0, nc = G - c0;
          if (vcu >= c0) for (int m = (vcu - c0) * NWAVES + wave; m < MT; m += nc * NWAVES) {
              const int isv = 0, row = m;
              const u32x2* src = (const u32x2*)((isv ? VB : KB) + (size_t)row * DATT) + lane;
              float* dstp = out + (row < MP ? (isv ? O_VP : O_KP) + (size_t)row * DATT : (isv ? O_VS : O_KS) + (size_t)(row - MP) * DATT);
              u32x2 w[4];
#pragma unroll
              for (int j = 0; j < 4; ++j) w[j] = src[64 * j];
#pragma unroll
              for (int j = 0; j < 4; ++j) ((f32x4*)dstp)[64 * j + lane] = (f32x4){__uint_as_float(w[j].x << 16), __uint_as_float(w[j].x & 0xffff0000u), __uint_as_float(w[j].y << 16), __uint_as_float(w[j].y & 0xffff0000u)};
          } }
    }
    GRID_BAR(2);

    if (IN(3)) {
        for (int row = gw; row < MT; row += NGW) {
            const u32x2* src = (const u32x2*)(VB + (size_t)row * DATT) + lane;
            float* dstp = out + (row < MP ? O_VP + (size_t)row * DATT : O_VS + (size_t)(row - MP) * DATT);
            u32x2 w[4];
#pragma unroll
            for (int j = 0; j < 4; ++j) w[j] = src[64 * j];
#pragma unroll
            for (int j = 0; j < 4; ++j) ((f32x4*)dstp)[64 * j + lane] = (f32x4){__uint_as_float(w[j].x << 16), __uint_as_float(w[j].x & 0xffff0000u), __uint_as_float(w[j].y << 16), __uint_as_float(w[j].y & 0xffff0000u)};
        }
        for (int m = gw; m < MT; m += NGW) {
            u32x4* ma = (u32x4*)(MIX + (size_t)m * DM + DCONV + 16 * lane); const bf16x8 a = ((const bf16x8*)ma)[0], c = ((const bf16x8*)ma)[1];
            float ya[16]; float sa = 0.f;
#pragma unroll
            for (int e = 0; e < 8; ++e) { ya[e] = bf2f((unsigned short)a[e]); ya[8 + e] = bf2f((unsigned short)c[e]); }
#pragma unroll
            for (int e = 0; e < 16; ++e) sa += ya[e] * ya[e];
            const float ra = __builtin_amdgcn_rsqf(wave_sum(sa) * (1.0f / DATT) + RMS_EPS);
            u32x4 o0, o1;
            o0.x = cvt_pk_bf16(ya[0] * ra, ya[1] * ra); o0.y = cvt_pk_bf16(ya[2] * ra, ya[3] * ra); o0.z = cvt_pk_bf16(ya[4] * ra, ya[5] * ra); o0.w = cvt_pk_bf16(ya[6] * ra, ya[7] * ra);
            o1.x = cvt_pk_bf16(ya[8] * ra, ya[9] * ra); o1.y = cvt_pk_bf16(ya[10] * ra, ya[11] * ra); o1.z = cvt_pk_bf16(ya[12] * ra, ya[13] * ra); o1.w = cvt_pk_bf16(ya[14] * ra, ya[15] * ra);
            ma[0] = o0; ma[1] = o1;
        }
    }
    GRID_BAR(3);

    if (IN(4)) { pg8::Gemm g{MIX, Wout_t, DM, DM}; pg8::StaticOrder S; S.init(MT, DM + DX, G, bx);
        EpiRes<0> E{args.in[I_XP], args.in[I_XS], XN, SS1, QPRE, QX};
        pg8::gemm_phase(ldsl, g, S, E);
        { const int nbusy = (MT / 256) * ((DM + DX) / 256) - G; const bool part = nbusy >= 0 && nbusy < G; const int nidle = part ? G - nbusy : G;
          if (!part || bx >= nbusy) { constexpr int I_UP = (DM / 64) * (DFF / 64);
              for (int it = (part ? bx - nbusy : bx) * NWAVES + wave; it < I_UP; it += nidle * NWAVES) { const int nb = DFF / 64, kb = it / nb, n0 = (it % nb) * 64;
                  p0_transpose_item(args.in[I_WUP], DM, DFF, Wup_t, kb * 64, n0, n0, args.in[I_GMLP], nullptr, lane); } } }
    }
    GRID_BAR(4);
    if (IN(6)) {
        for (int it = vcu; it < 256; it += G) {
            if (it < 128) { const int qb = it >> 2, h = it & 3, b = qb >> 4;
                att::BlockRef r0{QX + (size_t)qb * 256 * DX + h * HD, MKP + (size_t)b * NMEM * DX + h * HD, MKP + 512 * 512 + (size_t)b * NMEM * DX + h * HD, OX + (size_t)qb * 256 * DX + h * HD, nullptr, 1 << 24, NMEM, SS1, qb * 256};
                att::Seam S;
                att::attn_prime<DX, DX, false>(r0, (char*)lds, S);
                att::attn_block<DX, DX, DX, false>(r0, r0, (char*)lds, S);
                VM_WAIT(); __syncthreads();
            } else { const int sh = it - 128, b = sh >> 2, h = sh & 3; const size_t row0 = (size_t)(MP + b * DSEQ);
                sqa::item<false, false>(QX + row0 * DX + h * HD, DX, args.in[I_CMK] + (size_t)b * NMEM * DX + h * HD, args.in[I_CMV] + (size_t)b * NMEM * DX + h * HD, DX, NMEM / NWAVES,
                                        nullptr, nullptr, 0, nullptr, OX + row0 * DX + h * HD, DX, (char*)lds, SS1, (int)row0); }
        }
    }
    GRID_BAR(6);
    if (IN(7)) { pg8::Gemm g{OX, Wxo_t, DX, DX}; pg8::StaticOrder S; S.init(MT, DM, G, bx);
        EpiRes<1> E{nullptr, nullptr, XN, SS2, nullptr, nullptr};
        pg8::gemm_phase(ldsl, g, S, E);
        { const int nun = (MT / 256) * (DM / 256), nbusy = nun % G; const bool part = nun > G && nbusy > 0; const int nidle = part ? G - nbusy : G;
          if (!part || bx >= nbusy) { constexpr int I_DN = (DFF / 64) * (DM / 64);
              for (int it = (part ? bx - nbusy : bx) * NWAVES + wave; it < I_DN / 2; it += nidle * NWAVES) { const int nb = DM / 64, kb = it / nb, n0 = (it % nb) * 64;
                  p0_transpose_item(args.in[I_WDN], DFF, DM, Wdn_t, kb * 64, n0, n0, nullptr, nullptr, lane); } } }
    }
    GRID_BAR(7);
    if (IN(8)) { pg8::Gemm g{XN, Wup_t, DM, DM}; pg8::StaticOrder S; S.init(MT, DFF, G, bx);
        EpiScale<1> E{HB, DFF, SS2};
        pg8::gemm_phase(ldsl, g, S, E);
        { const int nun = (MT / 256) * (DFF / 256), nbusy = nun % G; const bool part = nbusy > 0; const int nidle = part ? G - nbusy : G;
          if (!part || bx >= nbusy) { constexpr int I_DN = (DFF / 64) * (DM / 64);
              for (int it = I_DN / 2 + (part ? bx - nbusy : bx) * NWAVES + wave; it < I_DN; it += nidle * NWAVES) { const int nb = DM / 64, kb = it / nb, n0 = (it % nb) * 64;
                  p0_transpose_item(args.in[I_WDN], DFF, DM, Wdn_t, kb * 64, n0, n0, nullptr, nullptr, lane); } } }
    }
    GRID_BAR(8);
    if (IN(9)) {
        { pg8::Gemm g{HB, Wdn_t, DFF, DFF}; pg8::StaticOrder S; S.init(MP, DM, G, bx);
          EpiRes<1> E{nullptr, nullptr, XN, SS3, nullptr, nullptr};
          pg8::gemm_phase(ldsl, g, S, E); }
        { pg8::Gemm g{HB, Wdn_t, DFF, DFF / 8}; pg8::SplitOrder S{MP / 256, DM / 256, (MS / 256) * (DM / 256), 8, DFF / 8, G, bx};
          EpiPart E{PART, MP, MS, DFF / 8};
          pg8::gemm_phase(ldsl, g, S, E); }
    }
    GRID_BAR(9);
    if (IN(10)) {
        f32x4 gfin[8]; load_row(args.in[I_GFINAL], lane, gfin);
        for (int m = gw; m < MT; m += NGW) {
            const u32x2* xr = (const u32x2*)(XN + (size_t)m * DM) + lane; f32x4* yo = (f32x4*)(out + (size_t)m * DM) + lane;
            f32x4 v[8];
#pragma unroll
            for (int j = 0; j < 8; ++j) { const u32x2 w = xr[64 * j]; v[j] = (f32x4){__uint_as_float(w.x << 16), __uint_as_float(w.x & 0xffff0000u), __uint_as_float(w.y << 16), __uint_as_float(w.y & 0xffff0000u)}; }
            float r;
            if (m < MP) {
                float s = (lane < 32) ? SS3[(size_t)lane * MT + m] : 0.f;
                r = __builtin_amdgcn_rsqf(wave_sum(s) * (1.0f / DM) + RMS_EPS);
            } else {
                float s = 0.f;
#pragma unroll
                for (int j = 0; j < 8; ++j) {
#pragma unroll
                    for (int sl = 0; sl < 8; ++sl) { const u32x2 w = ((const u32x2*)(PART + ((size_t)sl * MS + (m - MP)) * DM))[64 * j + lane];
                        v[j] += (f32x4){__uint_as_float(w.x << 16), __uint_as_float(w.x & 0xffff0000u), __uint_as_float(w.y << 16), __uint_as_float(w.y & 0xffff0000u)}; }
                    s += (v[j][0] * v[j][0] + v[j][1] * v[j][1]) + (v[j][2] * v[j][2] + v[j][3] * v[j][3]); }
                r = __builtin_amdgcn_rsqf(wave_sum(s) * (1.0f / DM) + RMS_EPS);
            }
#pragma unroll
            for (int j = 0; j < 8; ++j) yo[64 * j] = v[j] * r * gfin[j];
        }
    }
#undef IN
#undef GRID_BAR
}

extern "C" void kernel_launch(void* const* d_in, const int* in_sizes, int n_in, void* d_out, int out_size, void* d_ws, size_t ws_size, hipStream_t stream) {
    static int grid = 0;
    if (grid == 0) {
        if (n_in != 25 || (size_t)out_size != O_END || ws_size < WS_END) { fprintf(stderr, "kernel_launch: unexpected shapes (n_in %d, out %d, ws %zu)\n", n_in, out_size, ws_size); grid = -1; return; }
        int dev = 0, cus = 0;
        if (hipGetDevice(&dev) != hipSuccess || hipDeviceGetAttribute(&cus, hipDeviceAttributeMultiprocessorCount, dev) != hipSuccess) { grid = -1; return; }
        if (hipFuncSetAttribute((const void*)fox_fwd, hipFuncAttributeMaxDynamicSharedMemorySize, LDS_BYTES) != hipSuccess) { fprintf(stderr, "kernel_launch: hipFuncSetAttribute failed\n"); grid = -1; return; }
        (void)hipGetLastError();
        grid = cus;
    }
    if (grid < 0) return;
    if (hipMemsetAsync((char*)d_ws + WS_CTL, 0, CTL_ZERO_BYTES, stream) != hipSuccess) return;
    Args a{};
    for (int i = 0; i < 25; ++i) a.in[i] = (const float*)d_in[i];
    a.out = (float*)d_out; a.ws = (unsigned char*)d_ws;
    if (N_LAUNCHES == 1) { a.ph_lo = 0; a.ph_hi = N_PHASES; hipLaunchKernelGGL(fox_fwd, dim3(grid), dim3(NWAVES * 64), LDS_BYTES, stream, a); }
    else { for (int p = 0; p < N_PHASES; ++p) { a.ph_lo = p; a.ph_hi = p + 1; hipLaunchKernelGGL(fox_fwd, dim3(grid), dim3(NWAVES * 64), LDS_BYTES, stream, a); } }
}
```

```cpp
#include <hip/hip_runtime.h>
#include <hip/hip_bf16.h>
#include <cstdio>
#include <cstdint>

#define LAS __attribute__((address_space(3)))
#define GAS __attribute__((address_space(1)))
typedef unsigned short bf16_t;
typedef short bf16x8 __attribute__((ext_vector_type(8)));
typedef short s16x4 __attribute__((ext_vector_type(4)));
typedef float f32x2 __attribute__((ext_vector_type(2)));
typedef float f32x4 __attribute__((ext_vector_type(4)));
typedef float f32x16 __attribute__((ext_vector_type(16)));
typedef unsigned u32x2 __attribute__((ext_vector_type(2)));
typedef unsigned u32x4 __attribute__((ext_vector_type(4)));

constexpr int DM = 2048, NB_P = 2, SEQ = 4096, NB_S = 32, DSEQ = 32, PAST = 2048;
constexpr int DCONV = 1024, NH = 8, HD = 128, DATT = 1024, DIN = 6152, NMEM = 256, HX = 4, DX = 512, DFF = 8192;
constexpr int MP = NB_P * SEQ, MS = NB_S * DSEQ, MT = MP + MS;
constexpr int NIN = 6144;
constexpr float RMS_EPS = 1e-6f;
constexpr float LOG2E = 1.4426950408889634f;
constexpr float ATT_SCALE = 0.08838834764831845f;
constexpr int SKEYS = PAST + DSEQ;

constexpr size_t O_YP = 0, O_YS = O_YP + (size_t)MP * DM, O_KP = O_YS + (size_t)MS * DM, O_VP = O_KP + (size_t)MP * DATT, O_FP = O_VP + (size_t)MP * DATT,
                 O_CP = O_FP + (size_t)MP * NH, O_MKP = O_CP + (size_t)NB_P * 2 * DCONV, O_MVP = O_MKP + (size_t)NB_P * NMEM * DX, O_KS = O_MVP + (size_t)NB_P * NMEM * DX,
                 O_VS = O_KS + (size_t)MS * DATT, O_FS = O_VS + (size_t)MS * DATT, O_CS = O_FS + (size_t)MS * NH, O_END = O_CS + (size_t)NB_S * 2 * DCONV;

constexpr size_t MiB = 1u << 20;
constexpr size_t WS_CTL = 0, CTL_ZERO_BYTES = 64 * 1024;
constexpr size_t WS_WIN = 2 * MiB;
constexpr size_t WS_WOUT = WS_WIN + 26 * MiB;
constexpr size_t WS_WOUTR = WS_WOUT + 10 * MiB;
constexpr size_t WS_WXQ = WS_WOUTR + 8 * MiB;
constexpr size_t WS_WXKV = WS_WXQ + 2 * MiB;
constexpr size_t WS_WXO = WS_WXKV + 4 * MiB;
constexpr size_t WS_WUP = WS_WXO + 2 * MiB;
constexpr size_t WS_WDN = WS_WUP + 32 * MiB;
constexpr size_t WS_XN = WS_WDN + 32 * MiB;
constexpr size_t WS_MEMN = WS_XN + 36 * MiB;
constexpr size_t WS_X1 = WS_MEMN + 2 * MiB;
constexpr size_t WS_LOGF = WS_X1 + 72 * MiB;
constexpr size_t WS_BIASP = WS_LOGF + 1 * MiB;
constexpr size_t WS_BIASS = WS_BIASP + 1 * MiB;
constexpr size_t WS_SS = WS_BIASS + 3 * MiB;
constexpr size_t WS_MKP = WS_SS + 4 * MiB;
constexpr size_t WS_R0 = WS_MKP + 1 * MiB;
constexpr size_t WS_QPRE = WS_R0 + 1 * MiB;
constexpr size_t WS_ACT = WS_QPRE + 18 * MiB;
constexpr size_t WS_GB = WS_ACT;
constexpr size_t WS_U = WS_GB + 18 * MiB;
constexpr size_t WS_Q = WS_U + 18 * MiB;
constexpr size_t WS_K = WS_Q + 18 * MiB;
constexpr size_t WS_V = WS_K + 18 * MiB;
constexpr size_t WS_MIX = WS_V + 18 * MiB;
constexpr size_t WS_QX = WS_MIX + 36 * MiB;
constexpr size_t WS_OX = WS_QX + 9 * MiB;
constexpr size_t WS_H = WS_ACT;
constexpr size_t WS_PART = WS_ACT + 144 * MiB;
constexpr size_t WS_END = WS_PART + 64 * MiB;
static_assert(WS_OX + 9 * MiB <= WS_END, "activation overlay");

constexpr int CW_BAR = 4096;

constexpr int RING_BYTES = 131072;
constexpr int LDSCTL_OFF = RING_BYTES, MISC_OFF = LDSCTL_OFF + 320;
constexpr int SQA_ML_OFF = LDSCTL_OFF + 1024;
constexpr int SQA_FS_OFF = SQA_ML_OFF + 2048;
constexpr int SQA_Q_OFF = SQA_FS_OFF + 2048;
static_assert(SQA_Q_OFF + 8192 <= 147456, "LDS map");
constexpr int LDS_BYTES = 147456;
constexpr int NWAVES = 8;

#define LDS_WAIT() asm volatile("s_waitcnt lgkmcnt(0)" ::: "memory")
#define VM_WAIT() asm volatile("s_waitcnt vmcnt(0)" ::: "memory")
#define SBAR() __builtin_amdgcn_sched_barrier(0)

__device__ __forceinline__ unsigned cvt_pk_bf16(float lo, float hi) { unsigned r; asm volatile("v_cvt_pk_bf16_f32 %0, %1, %2" : "=v"(r) : "v"(lo), "v"(hi)); return r; }
__device__ __forceinline__ float bf2f(unsigned short b) { return __uint_as_float(((unsigned)b) << 16); }
__device__ __forceinline__ float wave_sum(float v) {
#pragma unroll
    for (int o = 1; o < 64; o <<= 1) v += __shfl_xor(v, o);
    return v;
}

namespace pg8 {
constexpr int BM = 256, BK = 64, HALF = 128, HTB = HALF * BK * 2, STAGE_BYTES = 8 * HTB, NXCD = 8, WGM = 8;
__host__ __device__ __forceinline__ int lds_byte(int r, int c) { const int st = (r >> 4) * 2 + (c >> 5), rr = r & 15, cc = c & 31, ob = rr * 64 + cc * 2; return st * 1024 + (ob ^ (((ob >> 9) & 1) << 5)); }
__host__ __device__ __forceinline__ void stage_rc(int b, int& R, int& C) { const int st = b / 1024, sb = b % 1024, swz = sb ^ (((sb >> 9) & 1) << 5); R = (st >> 1) * 16 + swz / 64; C = (st & 1) * 32 + (swz % 64) / 2; }
__host__ __device__ __forceinline__ int perm32(int rho) { const int n = rho >> 4, i = rho & 15; return 8 * (i >> 2) + 4 * n + (i & 3); }

struct Unit { int pm, pn, k0; };
struct Gemm { const bf16_t* A; const bf16_t* Bt; int ld, K; };

struct StaticOrder {
    int nM, nN, nwg, G, c;
    __host__ __device__ void init(int M, int N, int G_, int c_) { nM = M / BM; nN = N / BM; nwg = nM * nN; G = G_; c = c_; }
    __host__ __device__ bool next(int i, Unit& u) const {
        const long L = (long)i * G + c; if (L >= nwg) return false;
        int wgid = (int)L; { const int q = nwg / NXCD, r = nwg % NXCD, xcd = wgid % NXCD, off = wgid / NXCD; wgid = (xcd < r ? xcd * (q + 1) : r * (q + 1) + (xcd - r) * q) + off; }
        const int nig = WGM * nN, gid = wgid / nig, fm = gid * WGM, gsz = (nM - fm) < WGM ? (nM - fm) : WGM;
        u.pm = fm + ((wgid % nig) % gsz); u.pn = (wgid % nig) / gsz; u.k0 = 0; return true;
    }
};
struct SplitOrder {
    int pm0, nN, nu, ns, klen, G, c;
    __host__ __device__ bool next(int i, Unit& u) const { const int L = i * G + c; if (L >= nu * ns) return false; const int un = L / ns, sl = L % ns; u.pm = pm0 + un / nN; u.pn = un % nN; u.k0 = sl * klen; return true; }
};
struct TailOrder {
    int nN, nunits, G, c, skip;
    __host__ __device__ bool next(int i, Unit& u) const { const int j = c - (G - skip - nunits); if (i != 0 || j < 0 || j >= nunits) return false; u.pm = j / nN; u.pn = j % nN; u.k0 = 0; return true; }
};

template <class Epi, class Sched>
__device__ __forceinline__ void gemm_phase(LAS unsigned char* lds, const Gemm g, const Sched& S, const Epi& E) {
    const int tid = threadIdx.x, wid = __builtin_amdgcn_readfirstlane(tid >> 6), lane = tid & 63, wr = wid >> 2, wc = wid & 3, fr = lane & 15, fq = lane >> 4;
    const int K = g.K, nt = K / BK, ld = g.ld;
    unsigned voffA[2], voffB[2];
#pragma unroll
    for (int i = 0; i < 2; ++i) { int R, C; stage_rc(tid * 16 + i * 8192, R, C); const int Rb = (R & ~31) + perm32(R & 31);
        voffA[i] = (unsigned)(R * ld + C) * 2u; voffB[i] = (unsigned)(Rb * ld + C) * 2u; }
    const size_t kstep = (size_t)(BK * 2);
    const size_t hstep = (size_t)HALF * ld * 2;
    const size_t tstep = 2 * hstep;
    const unsigned ldsw = (unsigned)wid * 1024u;
    const int aoff = lds_byte(wr * 64 + fr, fq * 8), boff = lds_byte(wc * 32 + fr, fq * 8);
#define PG8_SA(b, h) (((b) * 2 + (h)) * HTB)
#define PG8_SB(b, h) ((4 + (b) * 2 + (h)) * HTB)
#define PG8_STAGE(bufoff, gbase, voff) do { _Pragma("unroll") for (int _i = 0; _i < 2; ++_i) \
        __builtin_amdgcn_global_load_lds((const unsigned*)((const char*)(gbase) + (voff)[_i]), (LAS unsigned*)(lds + (bufoff) + ldsw + _i * 8192), 16, 0, 0); } while (0)
#define PG8_LDA(dst, b, h) do { _Pragma("unroll") for (int m = 0; m < 4; ++m) _Pragma("unroll") for (int k = 0; k < 2; ++k) dst[m][k] = *(const LAS bf16x8*)(lds + PG8_SA(b, h) + aoff + m * 2048 + k * 1024); } while (0)
#define PG8_LDB(dst, b, h) do { _Pragma("unroll") for (int n = 0; n < 2; ++n) _Pragma("unroll") for (int k = 0; k < 2; ++k) dst[n][k] = *(const LAS bf16x8*)(lds + PG8_SB(b, h) + boff + n * 2048 + k * 1024); } while (0)
#define PG8_MMA(ai, bj, At, Bt) do { __builtin_amdgcn_s_setprio(1); _Pragma("unroll") for (int m = 0; m < 4; ++m) _Pragma("unroll") for (int n = 0; n < 2; ++n) _Pragma("unroll") for (int k = 0; k < 2; ++k) \
        acc[ai][bj][m][n] = __builtin_amdgcn_mfma_f32_16x16x32_bf16(Bt[n][k], At[m][k], acc[ai][bj][m][n], 0, 0, 0); __builtin_amdgcn_s_setprio(0); } while (0)
#define PG8_WAIT_V(n) asm volatile("s_waitcnt vmcnt(" #n ")" ::: "memory")
#define PG8_WAIT_L(n) asm volatile("s_waitcnt lgkmcnt(" #n ")" ::: "memory")
#define PG8_BAR __builtin_amdgcn_s_barrier()
#define PG8_SCHED __builtin_amdgcn_sched_barrier(0)
    Unit cur, nxt; int ui = 0;
    if (!S.next(0, cur)) return;
    f32x4 acc[2][2][4][2];
    bf16x8 At[4][2], B0[2][2], B1[2][2];
    const char* cA = (const char*)g.A + (size_t)cur.pm * tstep + (size_t)cur.k0 * 2; const char* cB = (const char*)g.Bt + (size_t)cur.pn * tstep + (size_t)cur.k0 * 2;
    PG8_STAGE(PG8_SB(0, 0), cB, voffB); PG8_STAGE(PG8_SB(0, 1), cB + hstep, voffB); PG8_STAGE(PG8_SA(0, 0), cA, voffA); PG8_STAGE(PG8_SA(0, 1), cA + hstep, voffA);
    E.init(acc, cur, wr, wc, fr, fq);
    if (wr == 1) PG8_BAR;
    PG8_WAIT_V(2); PG8_BAR;
    PG8_STAGE(PG8_SB(1, 0), cB + kstep, voffB); PG8_STAGE(PG8_SA(1, 0), cA + kstep, voffA); PG8_STAGE(PG8_SB(1, 1), cB + hstep + kstep, voffB);
    PG8_WAIT_V(6); PG8_BAR;
    for (;;) {
        const bool has_next = S.next(ui + 1, nxt);
        const char* nA = has_next ? (const char*)g.A + (size_t)nxt.pm * tstep + (size_t)nxt.k0 * 2 : cA; const char* nB = has_next ? (const char*)g.Bt + (size_t)nxt.pn * tstep + (size_t)nxt.k0 * 2 : cB;
        for (int t = 0; t < nt; t += 2) {
            const bool last = (t == nt - 2);
            const char* a1 = cA + (size_t)(t + 1) * kstep;
            const char* a2 = last ? nA : cA + (size_t)(t + 2) * kstep; const char* b2 = last ? nB : cB + (size_t)(t + 2) * kstep;
            const char* a3 = a2 + kstep; const char* b3 = b2 + kstep;
            PG8_LDB(B0, 0, 0); PG8_LDB(B1, 0, 1); PG8_SCHED; PG8_LDA(At, 0, 0); PG8_STAGE(PG8_SA(1, 1), a1 + hstep, voffA);
            PG8_WAIT_V(8); PG8_WAIT_L(0); PG8_BAR; PG8_MMA(0, 0, At, B0); PG8_MMA(0, 1, At, B1); PG8_BAR; PG8_SCHED;
            PG8_LDA(At, 0, 1); PG8_STAGE(PG8_SB(0, 0), b2, voffB); PG8_STAGE(PG8_SB(0, 1), b2 + hstep, voffB); PG8_STAGE(PG8_SA(0, 0), a2, voffA);
            PG8_WAIT_V(8); PG8_WAIT_L(0); PG8_BAR; PG8_MMA(1, 0, At, B0); PG8_MMA(1, 1, At, B1); PG8_BAR; PG8_SCHED;
            PG8_LDB(B0, 1, 0); PG8_LDB(B1, 1, 1); PG8_SCHED; PG8_LDA(At, 1, 0); PG8_STAGE(PG8_SA(0, 1), a2 + hstep, voffA);
            PG8_WAIT_V(8); PG8_WAIT_L(0); PG8_BAR; PG8_MMA(0, 0, At, B0); PG8_MMA(0, 1, At, B1); PG8_BAR; PG8_SCHED;
            PG8_LDA(At, 1, 1); PG8_STAGE(PG8_SB(1, 0), b3, voffB); PG8_STAGE(PG8_SB(1, 1), b3 + hstep, voffB); PG8_STAGE(PG8_SA(1, 0), a3, voffA);
            PG8_WAIT_V(8); PG8_WAIT_L(0); PG8_BAR; PG8_MMA(1, 0, At, B0); PG8_MMA(1, 1, At, B1); PG8_BAR; PG8_SCHED;
        }
        if (wr == 0) PG8_BAR;
        E(acc, cur, wr, wc, fr, fq);
        if (!has_next) break;
        E.init(acc, nxt, wr, wc, fr, fq);
        cur = nxt; cA = nA; cB = nB; ++ui;
        if (wr == 1) PG8_BAR;
    }
    PG8_WAIT_V(0);
    PG8_BAR;
#undef PG8_SA
#undef PG8_SB
#undef PG8_STAGE
#undef PG8_LDA
#undef PG8_LDB
#undef PG8_MMA
#undef PG8_WAIT_V
#undef PG8_WAIT_L
#undef PG8_BAR
#undef PG8_SCHED
}
}

__device__ __forceinline__ void acc_zero(f32x4 (&acc)[2][2][4][2]) {
#pragma unroll
    for (int a = 0; a < 2; ++a)
#pragma unroll
        for (int b = 0; b < 2; ++b)
#pragma unroll
            for (int m = 0; m < 4; ++m)
#pragma unroll
                for (int n = 0; n < 2; ++n) acc[a][b][m][n] = (f32x4){0.f, 0.f, 0.f, 0.f};
}
#define EPI_ZERO_INIT __device__ __forceinline__ void init(f32x4 (&acc)[2][2][4][2], const pg8::Unit&, int, int, int, int) const { acc_zero(acc); }
__device__ __forceinline__ u32x4 pack8(f32x4 a, f32x4 b) { u32x4 w; w.x = cvt_pk_bf16(a[0], a[1]); w.y = cvt_pk_bf16(a[2], a[3]); w.z = cvt_pk_bf16(b[0], b[1]); w.w = cvt_pk_bf16(b[2], b[3]); return w; }

template <int NP> __device__ __forceinline__ float row_rstd(const float* SS, int row, int fq) {
    float s = 0.f;
#pragma unroll
    for (int p = 0; p < NP / 4; ++p) s += SS[(size_t)(fq * (NP / 4) + p) * MT + row];
    s += __shfl_xor(s, 16); s += __shfl_xor(s, 32);
    return __builtin_amdgcn_rsqf(s * (1.0f / DM) + RMS_EPS);
}

struct EpiWin {
    bf16_t *GB, *U, *Q, *K, *V; float* out; const float* R0; float* QPRE;
    EPI_ZERO_INIT
    __device__ __forceinline__ void operator()(const f32x4 (&acc)[2][2][4][2], const pg8::Unit& u, int wr, int wc, int fr, int fq) const {
        const int pn = u.pn, rowb = u.pm * 256 + wr * 64 + fr, cw = wc * 32 + 8 * fq;
        if (pn >= 24) {
            float irr[2][4];
#pragma unroll
            for (int ai = 0; ai < 2; ++ai)
#pragma unroll
                for (int m = 0; m < 4; ++m) irr[ai][m] = R0[rowb + ai * 128 + m * 16];
#pragma unroll
            for (int ai = 0; ai < 2; ++ai)
#pragma unroll
                for (int m = 0; m < 4; ++m) { const int row = rowb + ai * 128 + m * 16; const float ir = 1.0f / irr[ai][m];
#pragma unroll
                    for (int bj = 0; bj < 2; ++bj) { float* o = QPRE + (size_t)row * DX + (pn - 24) * 256 + bj * 128 + cw; *(f32x4*)o = acc[ai][bj][m][0] * ir; *(f32x4*)(o + 4) = acc[ai][bj][m][1] * ir; } }
            return;
        }
        if (pn >= 4 && pn < 12) {
            const int ch = (pn - 4) * 128 + cw;
#pragma unroll
            for (int ai = 0; ai < 2; ++ai)
#pragma unroll
                for (int m = 0; m < 4; ++m) { const int row = rowb + ai * 128 + m * 16;
                    const f32x4 u0 = acc[ai][0][m][0] * acc[ai][1][m][0], u1 = acc[ai][0][m][1] * acc[ai][1][m][1];
                    *(u32x4*)(U + (size_t)row * DCONV + ch) = pack8(u0, u1);
                    if (row < MP) { const int t = row & (SEQ - 1); if (t >= SEQ - 2) { float* o = out + O_CP + ((size_t)(row / SEQ) * 2 + (t - (SEQ - 2))) * DCONV + ch; *(f32x4*)o = u0; *(f32x4*)(o + 4) = u1; } }
                    else { const int rs = row - MP, t = rs & (DSEQ - 1); if (t >= DSEQ - 2) { float* o = out + O_CS + ((size_t)(rs / DSEQ) * 2 + (t - (DSEQ - 2))) * DCONV + ch; *(f32x4*)o = u0; *(f32x4*)(o + 4) = u1; } }
                }
            return;
        }
        bf16_t* dst; float* fo = nullptr; int ct;
        if (pn < 4) { dst = GB; ct = pn * 256; }
        else if (pn < 16) { dst = Q; ct = (pn - 12) * 256; }
        else if (pn < 20) { dst = K; ct = (pn - 16) * 256; }
        else { dst = V; ct = (pn - 20) * 256; }
#pragma unroll
        for (int ai = 0; ai < 2; ++ai)
#pragma unroll
            for (int m = 0; m < 4; ++m) { const int row = rowb + ai * 128 + m * 16;
#pragma unroll
                for (int bj = 0; bj < 2; ++bj) { const size_t off = (size_t)row * 1024 + ct + bj * 128 + cw;
                    *(u32x4*)(dst + off) = pack8(acc[ai][bj][m][0], acc[ai][bj][m][1]);
                    if (fo) { *(f32x4*)(fo + off) = acc[ai][bj][m][0]; *(f32x4*)(fo + off + 4) = acc[ai][bj][m][1]; } } }
    }
};
struct EpiMem {
    bf16_t* MK; float* out;
    EPI_ZERO_INIT
    __device__ __forceinline__ void operator()(const f32x4 (&acc)[2][2][4][2], const pg8::Unit& u, int wr, int wc, int fr, int fq) const {
        const int rowb = u.pm * 256 + wr * 64 + fr, isv = u.pn >> 1, ct = (u.pn & 1) * 256 + wc * 32 + 8 * fq;
        bf16_t* dst = MK + (size_t)isv * (512 * 512); float* fo = out + (isv ? O_MVP : O_MKP);
#pragma unroll
        for (int ai = 0; ai < 2; ++ai)
#pragma unroll
            for (int m = 0; m < 4; ++m) { const int row = rowb + ai * 128 + m * 16;
#pragma unroll
                for (int bj = 0; bj < 2; ++bj) { const size_t off = (size_t)row * DX + ct + bj * 128;
                    *(u32x4*)(dst + off) = pack8(acc[ai][bj][m][0], acc[ai][bj][m][1]);
                    *(f32x4*)(fo + off) = acc[ai][bj][m][0]; *(f32x4*)(fo + off + 4) = acc[ai][bj][m][1]; } }
    }
};
template <int MODE> struct EpiRes {
    const float* baseP; const float* baseS;
    bf16_t* xb; float* SS;
    const float* QPRE; bf16_t* QX;
    __device__ __forceinline__ void init(f32x4 (&acc)[2][2][4][2], const pg8::Unit& u, int wr, int wc, int fr, int fq) const {
        const int rowb = u.pm * 256 + wr * 64 + fr, ct = u.pn * 256 + wc * 32 + 8 * fq;
        if (MODE == 0 && u.pn >= 8) {
#pragma unroll
            for (int ai = 0; ai < 2; ++ai)
#pragma unroll
                for (int m = 0; m < 4; ++m)
#pragma unroll
                    for (int bj = 0; bj < 2; ++bj) { const size_t off = (size_t)(rowb + ai * 128 + m * 16) * DX + (ct - DM) + bj * 128; acc[ai][bj][m][0] = *(const f32x4*)(QPRE + off); acc[ai][bj][m][1] = *(const f32x4*)(QPRE + off + 4); }
            return;
        }
        const float* base = (u.pm < MP / 256) ? baseP : baseS - (size_t)MP * DM;
#pragma unroll
        for (int ai = 0; ai < 2; ++ai)
#pragma unroll
            for (int m = 0; m < 4; ++m)
#pragma unroll
                for (int bj = 0; bj < 2; ++bj) { const size_t off = (size_t)(rowb + ai * 128 + m * 16) * DM + ct + bj * 128;
                    if (MODE == 0) { acc[ai][bj][m][0] = *(const f32x4*)(base + off); acc[ai][bj][m][1] = *(const f32x4*)(base + off + 4); }
                    else { const u32x4 w = *(const u32x4*)(xb + off);
                        acc[ai][bj][m][0] = (f32x4){__uint_as_float(w.x << 16), __uint_as_float(w.x & 0xffff0000u), __uint_as_float(w.y << 16), __uint_as_float(w.y & 0xffff0000u)};
                        acc[ai][bj][m][1] = (f32x4){__uint_as_float(w.z << 16), __uint_as_float(w.z & 0xffff0000u), __uint_as_float(w.w << 16), __uint_as_float(w.w & 0xffff0000u)}; } }
    }
    __device__ __forceinline__ void operator()(const f32x4 (&acc)[2][2][4][2], const pg8::Unit& u, int wr, int wc, int fr, int fq) const {
        const int rowb = u.pm * 256 + wr * 64 + fr, ct = u.pn * 256 + wc * 32 + 8 * fq;
        if (MODE == 0 && u.pn >= 8) {
#pragma unroll
            for (int ai = 0; ai < 2; ++ai)
#pragma unroll
                for (int m = 0; m < 4; ++m)
#pragma unroll
                    for (int bj = 0; bj < 2; ++bj) *(u32x4*)(QX + (size_t)(rowb + ai * 128 + m * 16) * DX + (ct - DM) + bj * 128) = pack8(acc[ai][bj][m][0], acc[ai][bj][m][1]);
            return;
        }
#pragma unroll
        for (int ai = 0; ai < 2; ++ai)
#pragma unroll
            for (int m = 0; m < 4; ++m) { const int row = rowb + ai * 128 + m * 16; float s = 0.f;
#pragma unroll
                for (int bj = 0; bj < 2; ++bj) { const f32x4 v0 = acc[ai][bj][m][0], v1 = acc[ai][bj][m][1];
                    *(u32x4*)(xb + (size_t)row * DM + ct + bj * 128) = pack8(v0, v1);
                    s += (v0[0] * v0[0] + v0[1] * v0[1]) + (v0[2] * v0[2] + v0[3] * v0[3]) + (v1[0] * v1[0] + v1[1] * v1[1]) + (v1[2] * v1[2] + v1[3] * v1[3]); }
                s += __shfl_xor(s, 16); s += __shfl_xor(s, 32);
                if (fq == 0) SS[(size_t)(u.pn * 4 + wc) * MT + row] = s; }
    }
};
struct EpiPlain {
    bf16_t* O; int ldc;
    EPI_ZERO_INIT
    __device__ __forceinline__ void operator()(const f32x4 (&acc)[2][2][4][2], const pg8::Unit& u, int wr, int wc, int fr, int fq) const {
        const int rowb = u.pm * 256 + wr * 64 + fr, ct = u.pn * 256 + wc * 32 + 8 * fq;
#pragma unroll
        for (int ai = 0; ai < 2; ++ai)
#pragma unroll
            for (int m = 0; m < 4; ++m)
#pragma unroll
                for (int bj = 0; bj < 2; ++bj) *(u32x4*)(O + (size_t)(rowb + ai * 128 + m * 16) * ldc + ct + bj * 128) = pack8(acc[ai][bj][m][0], acc[ai][bj][m][1]);
    }
};
struct EpiPart {
    bf16_t* P; int row0, nrows, klen;
    EPI_ZERO_INIT
    __device__ __forceinline__ void operator()(const f32x4 (&acc)[2][2][4][2], const pg8::Unit& u, int wr, int wc, int fr, int fq) const {
        const int rowb = u.pm * 256 + wr * 64 + fr - row0, ct = u.pn * 256 + wc * 32 + 8 * fq;
        bf16_t* base = P + (size_t)(u.k0 / klen) * nrows * DM;
#pragma unroll
        for (int ai = 0; ai < 2; ++ai)
#pragma unroll
            for (int m = 0; m < 4; ++m) { const int row = rowb + ai * 128 + m * 16;
#pragma unroll
                for (int bj = 0; bj < 2; ++bj) *(u32x4*)(base + (size_t)row * DM + ct + bj * 128) = pack8(acc[ai][bj][m][0], acc[ai][bj][m][1]); }
    }
};
template <int ACT> struct EpiScale {
    bf16_t* O; int ldc; const float* SS;
    EPI_ZERO_INIT
    __device__ __forceinline__ void operator()(const f32x4 (&acc)[2][2][4][2], const pg8::Unit& u, int wr, int wc, int fr, int fq) const {
        const int rowb = u.pm * 256 + wr * 64 + fr, ct = u.pn * 256 + wc * 32 + 8 * fq;
        float rs[2][4];
#pragma unroll
        for (int ai = 0; ai < 2; ++ai)
#pragma unroll
            for (int m = 0; m < 4; ++m) rs[ai][m] = row_rstd<32>(SS, rowb + ai * 128 + m * 16, fq);
#pragma unroll
        for (int ai = 0; ai < 2; ++ai)
#pragma unroll
            for (int m = 0; m < 4; ++m) { const int row = rowb + ai * 128 + m * 16; const float r = rs[ai][m];
#pragma unroll
                for (int bj = 0; bj < 2; ++bj) { f32x4 v0 = acc[ai][bj][m][0] * r, v1 = acc[ai][bj][m][1] * r;
                    if (ACT == 1) {
#pragma unroll
                        for (int e = 0; e < 4; ++e) { const float a = fmaxf(v0[e], 0.f), b = fmaxf(v1[e], 0.f); v0[e] = a * a; v1[e] = b * b; } }
                    *(u32x4*)(O + (size_t)row * ldc + ct + bj * 128) = pack8(v0, v1); } }
    }
};

typedef GAS unsigned gu32;
#define RLX_AGENT __ATOMIC_RELAXED, __HIP_MEMORY_SCOPE_AGENT
#define XB_TMO      128
#define XB_XCNT(j)  (256  + 64 * (j))
#define XB_XSUB(j)  (1280 + 64 * (j))
#define XB_XGEN(j)  (2304 + 64 * (j))
#define XB_TOP      3328
#define XB_TOPGEN   3392
#define XCD_BAR_WORDS 3456
#define XB_SPIN_CAP (1u << 18)
__device__ __forceinline__ unsigned xb_ld(unsigned* p)              { return __hip_atomic_load(p, __ATOMIC_RELAXED, __HIP_MEMORY_SCOPE_AGENT); }
__device__ __forceinline__ unsigned xb_add(unsigned* p, unsigned v) { return __hip_atomic_fetch_add(p, v, __ATOMIC_RELAXED, __HIP_MEMORY_SCOPE_AGENT); }
__device__ __forceinline__ unsigned xb_xcc_id() { return (unsigned)__builtin_amdgcn_s_getreg((3 << 11) | 20) & 0xFu; }
#define XB_SPIN(cond, bar) do { unsigned _sp = 0; while (cond) { __builtin_amdgcn_s_sleep(1); \
    if ((++_sp & 255u) == 0u) { if (xb_ld(&(bar)[XB_TMO])) break; if (_sp > XB_SPIN_CAP) { atomicAdd(&(bar)[XB_TMO], 1u); break; } } } } while (0)
struct XcdBarrier { unsigned* bar; unsigned x; volatile LAS unsigned* st; };
__device__ __forceinline__ XcdBarrier xcd_barrier_post(unsigned* bar, volatile LAS unsigned* st) {
    XcdBarrier b; b.bar = bar; b.x = xb_xcc_id(); b.st = st;
    if (threadIdx.x == 0) (void)xb_add(&bar[XB_XCNT(b.x)], 1u);
    return b;
}
__device__ __forceinline__ void xcd_barrier_complete(unsigned* bar, unsigned x, unsigned& nloc, unsigned& nx) {
    const unsigned G = gridDim.x * gridDim.y * gridDim.z;
    unsigned sum, cnt, mine, sp = 0u;
    for (;;) {
        sum = 0u; cnt = 0u; mine = 0u;
#pragma unroll
        for (unsigned j = 0; j < 16; ++j) { const unsigned c = xb_ld(&bar[XB_XCNT(j)]); sum += c; cnt += (c > 0u) ? 1u : 0u; mine = (j == x) ? c : mine; }
        if (sum == G) break;
        __builtin_amdgcn_s_sleep(1);
        if ((++sp & 255u) == 0u) { if (xb_ld(&bar[XB_TMO])) break; if (sp > XB_SPIN_CAP) { atomicAdd(&bar[XB_TMO], 1u); break; } }
    }
    nloc = mine > 0u ? mine : 1u; nx = cnt > 0u ? cnt : 1u;
}
__device__ __forceinline__ void xcd_barrier(const XcdBarrier& b) {
    asm volatile("s_waitcnt vmcnt(0)" ::: "memory");
    __syncthreads();
    if (threadIdx.x == 0) {
        unsigned* bar = b.bar;
        __builtin_amdgcn_s_waitcnt(0);
        unsigned nloc = b.st[0], nx = b.st[1];
        if (nloc == 0u) { xcd_barrier_complete(bar, b.x, nloc, nx); b.st[0] = nloc; b.st[1] = nx; }
        const unsigned old = xb_add(&bar[XB_XSUB(b.x)], 1u);
        const unsigned gen = old / nloc;
        if (old + 1u == (gen + 1u) * nloc) {
            __builtin_amdgcn_fence(__ATOMIC_RELEASE, "agent");
            asm volatile("s_waitcnt vmcnt(0)" ::: "memory");
            const unsigned og = xb_add(&bar[XB_TOP], 1u);
            const unsigned tg = og / nx;
            if (og + 1u == (tg + 1u) * nx) xb_add(&bar[XB_TOPGEN], 1u);
            else XB_SPIN(xb_ld(&bar[XB_TOPGEN]) == tg, bar);
            __builtin_amdgcn_fence(__ATOMIC_ACQUIRE, "agent");
            xb_add(&bar[XB_XGEN(b.x)], 1u);
            asm volatile("s_waitcnt vmcnt(0)" ::: "memory");
        } else {
            XB_SPIN(xb_ld(&bar[XB_XGEN(b.x)]) == gen, bar);
            __builtin_amdgcn_fence(__ATOMIC_ACQUIRE, "agent");
            asm volatile("s_waitcnt vmcnt(0)" ::: "memory");
        }
    }
    __syncthreads();
}

struct Args {
    const float* in[25];
    float* out; unsigned char* ws;
    int ph_lo, ph_hi;
};
enum { I_XP = 0, I_XS, I_CK, I_CV, I_CLF, I_CCONV, I_CMK, I_CMV, I_MEMP, I_GMIX, I_WIN, I_BF, I_CONVW, I_GCONV, I_GATTN, I_WOUT, I_GXATTN, I_GMEM, I_WXQ, I_WXKV, I_WXO, I_GMLP, I_WUP, I_WDN, I_GFINAL };

__device__ __forceinline__ unsigned f2bf(float f) { unsigned u = __builtin_bit_cast(unsigned, f); return (u + 0x7fffu + ((u >> 16) & 1u)) >> 16; }
__device__ __forceinline__ unsigned pk2(float lo, float hi) { return f2bf(lo) | (f2bf(hi) << 16); }
__device__ __forceinline__ void p0_transpose_item(const float* W, int K, int ldw, bf16_t* WT, int k0, int n0, int drow0, const float* gain, const float* gdiv, int lane) {
    const float* srcu = W + (size_t)k0 * ldw + n0;
    float v[64];
#pragma unroll
    for (int i = 0; i < 64; ++i) v[i] = srcu[(size_t)i * ldw + lane];
    if (gain) {
#pragma unroll
        for (int i = 0; i < 64; ++i) v[i] *= gain[k0 + i]; }
    if (gdiv) {
#pragma unroll
        for (int i = 0; i < 64; ++i) v[i] *= __builtin_amdgcn_rcpf(gdiv[k0 + i]); }
    bf16_t* dst = WT + (size_t)(drow0 + lane) * K + k0;
#pragma unroll
    for (int j = 0; j < 8; ++j) { u32x4 o; o.x = cvt_pk_bf16(v[8 * j], v[8 * j + 1]); o.y = cvt_pk_bf16(v[8 * j + 2], v[8 * j + 3]); o.z = cvt_pk_bf16(v[8 * j + 4], v[8 * j + 5]); o.w = cvt_pk_bf16(v[8 * j + 6], v[8 * j + 7]);
        *(u32x4*)(dst + 8 * j) = o; }
}
__device__ __forceinline__ int win_drow(int n0) {
    if (n0 < 1024 || n0 >= 3072) return n0;
    if (n0 < 2048) { const int c = n0 - 1024; return 1024 + 256 * (c >> 7) + (c & 127); }
    const int c = n0 - 2048; return 1024 + 256 * (c >> 7) + 128 + (c & 127);
}
__device__ __forceinline__ float log_sigmoidf(float a) { return fminf(a, 0.f) - log1pf(__expf(-fabsf(a))); }

__device__ __forceinline__ float block_excl_prefix(float T, LAS float* scr, int wave, int lane) {
    float v = T;
#pragma unroll
    for (int o = 1; o < 64; o <<= 1) { const float v2 = __shfl_up(v, o); if (lane >= o) v += v2; }
    __syncthreads();
    if (lane == 63) scr[wave] = v;
    __syncthreads();
    float off = 0.f;
#pragma unroll
    for (int w = 0; w < NWAVES; ++w) { const float t = scr[w]; if (w < wave) off += t; }
    return off + (v - T);
}

namespace att {
constexpr int NW = 8, QBLK = 32, KVBLK = 64, QB = NW * QBLK, D = 128;
constexpr int SHM_V = KVBLK * D * 2, SHM_K = KVBLK * D * 2;
constexpr int LDS_WS_OFF = 2 * SHM_V + 2 * SHM_K;
constexpr int LDS_BIAS_OFF = LDS_WS_OFF + NW * 64 * 4;
constexpr int LDS_TOTAL = LDS_BIAS_OFF + 4096 * 4;
constexpr float C2 = LOG2E * ATT_SCALE;
constexpr float THR2 = 16.f;
#define KSWZ(row, colB) ((row) * 256 + ((colB) ^ (((row) & 7) << 4)))
__device__ __forceinline__ int v_st(int k, int c) { const int kk = (k & ~0xC) | ((k & 4) << 1) | ((k & 8) >> 1); return ((kk >> 3) * 4 + (c >> 5)) * 512 + ((kk & 7) * 32 + (c & 31)) * 2; }
__device__ __forceinline__ int v_rd_base(int lane) { return ((lane & 3) << 3) | (((lane >> 2) & 3) << 6) | (((lane >> 4) & 1) << 5) | (((lane >> 5) & 1) << 8); }
constexpr int v_rd_off(int d0, int ks, int half) { return d0 * 512 + ks * 4096 + half * 2048; }
__device__ __forceinline__ int crow(int r, int hi) { return (r & 3) + 8 * (r >> 2) + 4 * hi; }
__device__ __forceinline__ bf16x8 load8(const bf16_t* p) { return *reinterpret_cast<const bf16x8*>(p); }
__device__ __forceinline__ void mask_tile(f32x16& p0, f32x16& p1, int dq) {
    const float NEG = -__builtin_inff();
#pragma unroll
    for (int r = 0; r < 16; ++r) { const int c = (r & 3) + 8 * (r >> 2); if (dq - c < 0) p0[r] = NEG; if (dq - c - 32 < 0) p1[r] = NEG; }
}
template <bool BIAS>
__device__ __forceinline__ void partialSM(f32x16& p0, f32x16& p1, float& m_reg, float& mn, float& alpha, const float* bl  , float c2) {
    if (BIAS) {
#pragma unroll
        for (int g = 0; g < 4; ++g) { const f32x4 b0 = *(const f32x4*)(bl + 8 * g), b1 = *(const f32x4*)(bl + 32 + 8 * g);
#pragma unroll
            for (int i = 0; i < 4; ++i) { p0[4 * g + i] = fmaf(p0[4 * g + i], c2, b0[i]); p1[4 * g + i] = fmaf(p1[4 * g + i], c2, b1[i]); } }
    } else {
#pragma unroll
        for (int r = 0; r < 16; ++r) { p0[r] *= c2; p1[r] *= c2; }
    }
    float pmax = p0[0];
#pragma unroll
    for (int r = 1; r < 16; ++r) pmax = fmaxf(pmax, p0[r]);
#pragma unroll
    for (int r = 0; r < 16; ++r) pmax = fmaxf(pmax, p1[r]);
    { auto rr = __builtin_amdgcn_permlane32_swap(__float_as_uint(pmax), __float_as_uint(pmax), false, false);
      pmax = fmaxf(__uint_as_float(rr[0]), __uint_as_float(rr[1])); }
    if (__builtin_expect(__all(pmax - m_reg <= THR2), 1)) { mn = m_reg; alpha = 1.f; }
    else { mn = fmaxf(m_reg, pmax); alpha = __builtin_amdgcn_exp2f(m_reg - mn); m_reg = mn; }
#pragma unroll
    for (int r = 0; r < 16; ++r) { p0[r] -= mn; p1[r] -= mn; }
#pragma unroll
    for (int r = 0; r < 16; ++r) p0[r] = __builtin_amdgcn_exp2f(p0[r]);
}
__device__ __forceinline__ void finishSM(f32x16& p0, f32x16& p1, float alpha, float& l_reg, bf16x8& pa0, bf16x8& pa1, bf16x8& pa2, bf16x8& pa3) {
#pragma unroll
    for (int r = 0; r < 16; ++r) p1[r] = __builtin_amdgcn_exp2f(p1[r]);
    float ps = 0;
#pragma unroll
    for (int r = 0; r < 16; ++r) ps += p0[r];
#pragma unroll
    for (int r = 0; r < 16; ++r) ps += p1[r];
    { auto rr = __builtin_amdgcn_permlane32_swap(__float_as_uint(ps), __float_as_uint(ps), false, false);
      ps = __uint_as_float(rr[0]) + __uint_as_float(rr[1]); }
    l_reg = l_reg * alpha + ps;
#define PK4(P, B_, OUT) do { unsigned a0 = cvt_pk_bf16(P[B_+0], P[B_+1]), a1 = cvt_pk_bf16(P[B_+2], P[B_+3]);                          \
        unsigned b0 = cvt_pk_bf16(P[B_+4], P[B_+5]), b1 = cvt_pk_bf16(P[B_+6], P[B_+7]);                                             \
        auto r0 = __builtin_amdgcn_permlane32_swap(a0, b0, false, false); auto r1 = __builtin_amdgcn_permlane32_swap(a1, b1, false, false); \
        u32x4 w = {r0[0], r1[0], r0[1], r1[1]}; OUT = *reinterpret_cast<bf16x8*>(&w); } while (0)
    PK4(p0, 0, pa0); PK4(p0, 8, pa1); PK4(p1, 0, pa2); PK4(p1, 8, pa3);
#undef PK4
}
template <int KB>
__device__ __forceinline__ void qkt(f32x16& p0, f32x16& p1, const char* K_lds, int r32, int hi, const bf16x8* qr) {
    p0 = f32x16{}; p1 = f32x16{};
    const char* kb[4];
#pragma unroll
    for (int dd = 0; dd < 4; ++dd) kb[dd] = K_lds + KB * SHM_K + KSWZ(r32, (dd * 16 + hi * 8) * 2);
#pragma unroll
    for (int d0 = 0; d0 < 8; ++d0) { const char* a = kb[d0 & 3] + (d0 >> 2) * 128;
        bf16x8 b0 = *reinterpret_cast<const bf16x8*>(a);
        bf16x8 b1 = *reinterpret_cast<const bf16x8*>(a + 32 * 256);
        p0 = __builtin_amdgcn_mfma_f32_32x32x16_bf16(b0, qr[d0], p0, 0, 0, 0);
        p1 = __builtin_amdgcn_mfma_f32_32x32x16_bf16(b1, qr[d0], p1, 0, 0, 0); }
}
template <int VB>
__device__ __forceinline__ void pv_tile(f32x16* o, int vb0, bf16x8 pa0, bf16x8 pa1, bf16x8 pa2, bf16x8 pa3) {
#define TRRD(dst, off) asm volatile("ds_read_b64_tr_b16 %0, %1 offset:%2" : "=&v"(dst) : "v"(vb0), "i"(off) : "memory")
#define PV_D0(d0) do { s16x4 l0, l1, l2, l3, h0, h1, h2, h3; constexpr int b_ = VB * SHM_V + v_rd_off(d0, 0, 0); \
        TRRD(l0, b_); TRRD(h0, b_ + 2048); TRRD(l1, b_ + 4096); TRRD(h1, b_ + 6144); TRRD(l2, b_ + 8192); TRRD(h2, b_ + 10240); TRRD(l3, b_ + 12288); TRRD(h3, b_ + 14336); \
        asm volatile("s_waitcnt lgkmcnt(0)" ::: "memory"); SBAR();   \
        o[d0] = __builtin_amdgcn_mfma_f32_32x32x16_bf16(pa0, (bf16x8){l0[0], l0[1], l0[2], l0[3], h0[0], h0[1], h0[2], h0[3]}, o[d0], 0, 0, 0);   \
        o[d0] = __builtin_amdgcn_mfma_f32_32x32x16_bf16(pa1, (bf16x8){l1[0], l1[1], l1[2], l1[3], h1[0], h1[1], h1[2], h1[3]}, o[d0], 0, 0, 0);   \
        o[d0] = __builtin_amdgcn_mfma_f32_32x32x16_bf16(pa2, (bf16x8){l2[0], l2[1], l2[2], l2[3], h2[0], h2[1], h2[2], h2[3]}, o[d0], 0, 0, 0);   \
        o[d0] = __builtin_amdgcn_mfma_f32_32x32x16_bf16(pa3, (bf16x8){l3[0], l3[1], l3[2], l3[3], h3[0], h3[1], h3[2], h3[3]}, o[d0], 0, 0, 0); } while (0)
    PV_D0(0); PV_D0(1); PV_D0(2); PV_D0(3);
#undef PV_D0
#undef TRRD
}
struct BlockRef { const bf16_t* Q; const bf16_t* K; const bf16_t* V; bf16_t* O; const float* bias; int P0; int skv; const float* SS; int row0; };
struct Seam { bf16x8 qr[8]; bf16x8 st_v0, st_v1, st_k0, st_k1; };
__device__ __forceinline__ int blk_jhi(const BlockRef& b) { int j = (b.P0 + QB - 1) / KVBLK + 1; if (j > b.skv / KVBLK) j = b.skv / KVBLK; return j; }
template <bool BIAS> __device__ __forceinline__ void load_bias(const BlockRef& b, char* lds) {
    if (BIAS) { const int nk = blk_jhi(b) * KVBLK; float* bl = (float*)(lds + LDS_BIAS_OFF);
        for (int i = threadIdx.x * 4; i < nk; i += 2048) *(f32x4*)(bl + i) = *(const f32x4*)(b.bias + i); }
}
#define ROW(p, S_, k0, rr) ((p) + (size_t)((k0) + (rr)) * (S_) + sc)
#define VMW() asm volatile("s_waitcnt vmcnt(0)" ::: "memory")
#define VMWN(n) asm volatile("s_waitcnt vmcnt(%0)" :: "i"(n) : "memory")
#define SLOAD_H(Kp, Vp, k0) do { S.st_v0 = load8(ROW(Vp, KS, k0, sr)); S.st_v1 = load8(ROW(Vp, KS, k0, 32 + sr));              \
                         S.st_k0 = load8(ROW(Kp, KS, k0, sr)); S.st_k1 = load8(ROW(Kp, KS, k0, 32 + sr)); } while (0)
#define SWRITE_HK(bf) do { *(bf16x8*)(K_lds + (bf) * SHM_K + kws) = S.st_k0; *(bf16x8*)(K_lds + (bf) * SHM_K + kws + 32 * 256) = S.st_k1; } while (0)
#define SWRITE_HV(bf) do { *(bf16x8*)(V_lds + (bf) * SHM_V + vst0) = S.st_v0; *(bf16x8*)(V_lds + (bf) * SHM_V + vst1) = S.st_v1; } while (0)
#define SWRITE_H(bf) do { SWRITE_HV(bf); SWRITE_HK(bf); } while (0)
template <int QS, int KS, bool BIAS>
__device__ __forceinline__ void attn_prime(const BlockRef& cur, char* lds, Seam& S) {
    const int tid = threadIdx.x, wid = __builtin_amdgcn_readfirstlane(tid >> 6), lane = tid & 63, r32 = lane & 31, hi = lane >> 5;
    const int sr = tid >> 4, sc = (tid & 15) * 8, kws = KSWZ(sr, sc * 2); char* K_lds = lds + 2 * SHM_V;
#pragma unroll
    for (int d0 = 0; d0 < 8; ++d0) S.qr[d0] = load8(cur.Q + (size_t)(wid * QBLK + r32) * QS + d0 * 16 + hi * 8);
    SLOAD_H(cur.K, cur.V, 0); VMW(); SWRITE_HK(0);
    load_bias<BIAS>(cur, lds);
    __syncthreads();
}
template <int QS, int KS, int OS, bool BIAS>
__device__ __forceinline__ void attn_block(const BlockRef& cur, const BlockRef& nxt, char* lds, Seam& S) {
    const int tid = threadIdx.x, wid = __builtin_amdgcn_readfirstlane(tid >> 6), lane = tid & 63, r32 = lane & 31, hi = lane >> 5;
    const int NT = blk_jhi(cur);
    const int qlo = cur.P0 + wid * QBLK, qm = qlo + r32 - 4 * hi;
    char* V_lds = lds; char* K_lds = lds + 2 * SHM_V;
    float* ws = (float*)(lds + LDS_WS_OFF) + wid * 64; float* li_l = ws, * al_l = ws + 32;
    const float* bias_l = (const float*)(lds + LDS_BIAS_OFF) + 4 * hi;
    float m_reg = -1e30f, l_reg = 0; f32x16 o[4] = {};
    float c2 = C2;
    if (cur.SS) { float s_ = 0.f; const int row_ = cur.row0 + wid * QBLK + r32;
#pragma unroll 8
        for (int p_ = 0; p_ < 32; ++p_) s_ += cur.SS[(size_t)p_ * MT + row_];
        c2 = C2 * __builtin_amdgcn_rsqf(s_ * (1.0f / DM) + RMS_EPS); }
    const int sr = tid >> 4, sc = (tid & 15) * 8, vst0 = v_st(sr, sc), vst1 = v_st(32 + sr, sc), kws = KSWZ(sr, sc * 2);
    const int vb0 = (int)(uintptr_t)V_lds + v_rd_base(lane);
    const bf16_t* Kh = cur.K; const bf16_t* Vh = cur.V;
#define RESC(a) do { if (__any((a) < 1.f)) { if (hi == 0) al_l[r32] = (a); asm volatile("s_waitcnt lgkmcnt(0)" ::: "memory");              \
                     for (int d_ = 0; d_ < 4; ++d_) for (int r = 0; r < 16; ++r) o[d_][r] *= al_l[crow(r, hi)]; } } while (0)
#define KBASE(t) ((t) * KVBLK)
#define MASKT(P0_, P1_, t) do { const int kb_ = KBASE(t); if (kb_ + KVBLK - 1 > qlo) mask_tile(P0_, P1_, qm - kb_); } while (0)
    constexpr int NQL = 8;
#define SEAM_K0() do { VMWN(NQL); SWRITE_HK(0); SBAR(); } while (0)
    f32x16 pA0, pA1, pB0, pB1; float mnA, mnB, alA, alB; bf16x8 pa0, pa1, pa2, pa3;
    SWRITE_HV(0); SBAR();
    if (NT > 1) { SLOAD_H(Kh, Vh, KBASE(1)); }
    SBAR(); qkt<0>(pA0, pA1, K_lds, r32, hi, S.qr);
    MASKT(pA0, pA1, 0); partialSM<BIAS>(pA0, pA1, m_reg, mnA, alA, bias_l + KBASE(0), c2);
    if (NT > 1) { VMW(); SWRITE_H(1); }
    __syncthreads();
#define HALF_STEP(PX0, PX1, mnX, alX, PY0, PY1, alY, t, KB, VB, SB) do {                                                      \
        SBAR(); qkt<KB>(PX0, PX1, K_lds, r32, hi, S.qr);                                             \
        finishSM(PY0, PY1, alY, l_reg, pa0, pa1, pa2, pa3); SBAR();                                                           \
        if ((t) + 1 < NT) { SLOAD_H(Kh, Vh, KBASE((t) + 1)); SBAR(); }                                               \
        pv_tile<VB>(o, vb0, pa0, pa1, pa2, pa3); MASKT(PX0, PX1, (t)); partialSM<BIAS>(PX0, PX1, m_reg, mnX, alX, bias_l + KBASE(t), c2);                                        \
        __syncthreads();                                                                                                      \
        if ((t) + 1 < NT) { VMW(); SWRITE_H(SB); }                                                                          \
        RESC(alX); __syncthreads(); } while (0)
    for (int t = 1; t + 1 < NT; t += 2) {
        HALF_STEP(pB0, pB1, mnB, alB, pA0, pA1, alA, t, 1, 0, 0);
        HALF_STEP(pA0, pA1, mnA, alA, pB0, pB1, alB, t + 1, 0, 1, 1);
    }
    const bool even = (NT & 1) == 0;
    if (even) { SBAR(); qkt<1>(pB0, pB1, K_lds, r32, hi, S.qr); SBAR(); }
    SLOAD_H(nxt.K, nxt.V, 0); SBAR();
#pragma unroll
    for (int d0 = 0; d0 < 8; ++d0) S.qr[d0] = load8(nxt.Q + (size_t)(wid * QBLK + r32) * QS + d0 * 16 + hi * 8);
    SBAR();
    finishSM(pA0, pA1, alA, l_reg, pa0, pa1, pa2, pa3); SBAR();
    pv_tile<0>(o, vb0, pa0, pa1, pa2, pa3);
    if (even) { MASKT(pB0, pB1, NT - 1); partialSM<BIAS>(pB0, pB1, m_reg, mnB, alB, bias_l + KBASE(NT - 1), c2); __syncthreads(); RESC(alB);
        finishSM(pB0, pB1, alB, l_reg, pa0, pa1, pa2, pa3); SBAR(); pv_tile<1>(o, vb0, pa0, pa1, pa2, pa3); }
    SBAR(); SEAM_K0();
    if (hi == 0) li_l[r32] = l_reg; asm volatile("s_waitcnt lgkmcnt(0)" ::: "memory");
    float rli[16];
#pragma unroll
    for (int r = 0; r < 16; ++r) rli[r] = __builtin_amdgcn_rcpf(li_l[crow(r, hi)]);
    bf16_t* Ow = cur.O + (size_t)(wid * QBLK) * OS;
#pragma unroll
    for (int r = 0; r < 16; ++r) { const int orow = crow(r, hi);
#pragma unroll
        for (int d0 = 0; d0 < 4; ++d0) { const float v = o[d0][r] * rli[r];
            const float vn = __shfl_xor(v, 1);
            if ((r32 & 1) == 0) *(unsigned*)(Ow + (size_t)orow * OS + d0 * 32 + r32) = cvt_pk_bf16(v, vn); } }
    load_bias<BIAS>(nxt, lds);
    __syncthreads();
#undef RESC
#undef KBASE
#undef MASKT
#undef SEAM_K0
#undef HALF_STEP
}
#undef ROW
#undef VMWN
#undef SLOAD_H
#undef SWRITE_HK
#undef SWRITE_HV
#undef SWRITE_H
}

namespace sqa {
using att::crow; using att::v_st; using att::v_rd_base; using att::v_rd_off; using att::C2;
template <bool BIAS, bool TAIL>
__device__ __forceinline__ void item(const bf16_t* Q, int QS, const float* Kc, const float* Vc, int CS, int KPW, const bf16_t* Kn, const bf16_t* Vn, int NS,
                                     const float* bias, bf16_t* O, int OS, char* lds, const float* SS, int row0) {
    int tid = threadIdx.x; asm volatile("" : "+v"(tid));
    const int wid = __builtin_amdgcn_readfirstlane(tid >> 6), lane = tid & 63, r32 = lane & 31, hi = lane >> 5;
    char* Kl = lds + wid * 16384; char* Vl = Kl + 8192;
    float* fs = (float*)(lds + SQA_FS_OFF) + wid * 64;
    float* MLm = (float*)(lds + SQA_ML_OFF); float* MLl = MLm + 256;
    char* Ql = lds + SQA_Q_OFF;
    { const int qrow = tid >> 4, qch = tid & 15; *(bf16x8*)(Ql + KSWZ(qrow, qch * 16)) = *(const bf16x8*)(Q + (size_t)qrow * QS + qch * 8); }
    __syncthreads();
    float m_reg = -1e30f, l_reg = 0.f; f32x16 o[4] = {};
    float c2 = C2;
    if (SS) { float s_ = 0.f;
#pragma unroll 8
        for (int p_ = 0; p_ < 32; ++p_) s_ += SS[(size_t)p_ * MT + row0 + r32];
        c2 = C2 * __builtin_amdgcn_rsqf(s_ * (1.0f / DM) + RMS_EPS); }
    const int vb0 = (int)(uintptr_t)Vl + v_rd_base(lane);
    const int lrow = lane >> 5, lcol = (lane & 31) * 4;
    const int kbeg = wid * KPW, nhalf = KPW / 16;
    const float* kp = Kc + (size_t)kbeg * CS; const float* vp = Vc + (size_t)kbeg * CS;
    const int loff = lrow * CS + lcol;
    int kwb[4];
#pragma unroll
    for (int j = 0; j < 4; ++j) kwb[j] = lrow * 256 + ((lcol * 2) ^ (lrow << 4) ^ (j << 5));
    const int vwb = (lcol >> 5) * 512 + lrow * 64 + (lcol & 31) * 2;
    f32x4 ks[8], vs[8];
#define SQA_LOADH(dst, base, hidx) do { _Pragma("unroll") for (int i_ = 0; i_ < 8; ++i_) dst[i_] = *(const f32x4*)((base) + (size_t)((hidx) * 16 + 2 * i_) * CS + loff); } while (0)
#define SQA_TRRD(dst, off) asm volatile("ds_read_b64_tr_b16 %0, %1 offset:%2" : "=&v"(dst) : "v"(vb0), "i"(off) : "memory")
#define SQA_TILE(bias_ptr, causal) do {                                                                                                   \
        f32x16 p = f32x16{};                                                                                                              \
        { int kb_[4]; _Pragma("unroll") for (int dd = 0; dd < 4; ++dd) kb_[dd] = KSWZ(r32, (dd * 16 + hi * 8) * 2);                         \
          _Pragma("unroll") for (int d0 = 0; d0 < 8; ++d0) { const bf16x8 a = *(const bf16x8*)(Kl + kb_[d0 & 3] + (d0 >> 2) * 128);       \
            const bf16x8 q_ = *(const bf16x8*)(Ql + kb_[d0 & 3] + (d0 >> 2) * 128);                                                        \
            p = __builtin_amdgcn_mfma_f32_32x32x16_bf16(a, q_, p, 0, 0, 0); } }                                                            \
        if (BIAS) { _Pragma("unroll") for (int g = 0; g < 4; ++g) { const f32x4 b = *(const f32x4*)((bias_ptr) + 4 * hi + 8 * g);         \
                _Pragma("unroll") for (int i = 0; i < 4; ++i) p[4 * g + i] = fmaf(p[4 * g + i], c2, b[i]); } }                              \
        else { _Pragma("unroll") for (int r = 0; r < 16; ++r) p[r] *= c2; }                                                                 \
        if (causal) { _Pragma("unroll") for (int r = 0; r < 16; ++r) if (crow(r, hi) > r32) p[r] = -__builtin_inff(); }                      \
        float pmax = p[0]; _Pragma("unroll") for (int r = 1; r < 16; ++r) pmax = fmaxf(pmax, p[r]);                                        \
        { auto rr = __builtin_amdgcn_permlane32_swap(__float_as_uint(pmax), __float_as_uint(pmax), false, false);                          \
          pmax = fmaxf(__uint_as_float(rr[0]), __uint_as_float(rr[1])); }                                                                  \
        const float mn = fmaxf(m_reg, pmax), alpha = __builtin_amdgcn_exp2f(m_reg - mn); m_reg = mn;                                      \
        float ps = 0.f; _Pragma("unroll") for (int r = 0; r < 16; ++r) { p[r] = __builtin_amdgcn_exp2f(p[r] - mn); ps += p[r]; }            \
        { auto rr = __builtin_amdgcn_permlane32_swap(__float_as_uint(ps), __float_as_uint(ps), false, false);                              \
          ps = __uint_as_float(rr[0]) + __uint_as_float(rr[1]); }                                                                          \
        l_reg = l_reg * alpha + ps;                                                                                                        \
        if (__any(alpha < 1.f)) { if (hi == 0) fs[r32] = alpha; LDS_WAIT();                                                                \
            _Pragma("unroll") for (int d_ = 0; d_ < 4; ++d_) _Pragma("unroll") for (int r = 0; r < 16; ++r) o[d_][r] *= fs[crow(r, hi)]; }     \
        bf16x8 pa0, pa1;                                                                                                                   \
        { unsigned a0 = cvt_pk_bf16(p[0], p[1]), a1 = cvt_pk_bf16(p[2], p[3]), b0 = cvt_pk_bf16(p[4], p[5]), b1 = cvt_pk_bf16(p[6], p[7]);     \
          auto r0 = __builtin_amdgcn_permlane32_swap(a0, b0, false, false); auto r1 = __builtin_amdgcn_permlane32_swap(a1, b1, false, false); \
          u32x4 w = {r0[0], r1[0], r0[1], r1[1]}; pa0 = *reinterpret_cast<bf16x8*>(&w); }                                                  \
        { unsigned a0 = cvt_pk_bf16(p[8], p[9]), a1 = cvt_pk_bf16(p[10], p[11]), b0 = cvt_pk_bf16(p[12], p[13]), b1 = cvt_pk_bf16(p[14], p[15]); \
          auto r0 = __builtin_amdgcn_permlane32_swap(a0, b0, false, false); auto r1 = __builtin_amdgcn_permlane32_swap(a1, b1, false, false); \
          u32x4 w = {r0[0], r1[0], r0[1], r1[1]}; pa1 = *reinterpret_cast<bf16x8*>(&w); }                                                  \
        _Pragma("unroll") for (int d0 = 0; d0 < 4; ++d0) { s16x4 l0, h0, l1, h1;                                                           \
            if (d0 == 0) { SQA_TRRD(l0, 0); SQA_TRRD(h0, 2048); SQA_TRRD(l1, 4096); SQA_TRRD(h1, 6144); }                                   \
            else if (d0 == 1) { SQA_TRRD(l0, 512); SQA_TRRD(h0, 2560); SQA_TRRD(l1, 4608); SQA_TRRD(h1, 6656); }                            \
            else if (d0 == 2) { SQA_TRRD(l0, 1024); SQA_TRRD(h0, 3072); SQA_TRRD(l1, 5120); SQA_TRRD(h1, 7168); }                           \
            else { SQA_TRRD(l0, 1536); SQA_TRRD(h0, 3584); SQA_TRRD(l1, 5632); SQA_TRRD(h1, 7680); }                                        \
            asm volatile("s_waitcnt lgkmcnt(0)" ::: "memory"); SBAR();                                                                    \
            o[d0] = __builtin_amdgcn_mfma_f32_32x32x16_bf16(pa0, (bf16x8){l0[0], l0[1], l0[2], l0[3], h0[0], h0[1], h0[2], h0[3]}, o[d0], 0, 0, 0); \
            o[d0] = __builtin_amdgcn_mfma_f32_32x32x16_bf16(pa1, (bf16x8){l1[0], l1[1], l1[2], l1[3], h1[0], h1[1], h1[2], h1[3]}, o[d0], 0, 0, 0); } \
        asm volatile("" ::: "memory");                                                                                                     \
    } while (0)
    SQA_LOADH(ks, kp, 0); SQA_LOADH(vs, vp, 0);
    for (int hh = 0; hh < nhalf; ++hh) {
        const int h = hh & 1; char* Kh_ = Kl + h * 4096; char* Vh_ = Vl + h * 4096 + vwb;
#pragma unroll
        for (int i = 0; i < 8; ++i) { u32x2 w; w.x = cvt_pk_bf16(ks[i][0], ks[i][1]); w.y = cvt_pk_bf16(ks[i][2], ks[i][3]);
            *(u32x2*)(Kh_ + kwb[i & 3] + (2 * i) * 256) = w; }
        if (hh + 1 < nhalf) SQA_LOADH(ks, kp, hh + 1);
#pragma unroll
        for (int i = 0; i < 8; ++i) { u32x2 w; w.x = cvt_pk_bf16(vs[i][0], vs[i][1]); w.y = cvt_pk_bf16(vs[i][2], vs[i][3]);
            *(u32x2*)(Vh_ + ((i >> 1) & 1) * 2048 + (i & 1) * 128 + (i >> 2) * 256) = w; }
        if (hh + 1 < nhalf) SQA_LOADH(vs, vp, hh + 1);
        if (h == 1) { asm volatile("" ::: "memory"); SQA_TILE(bias + kbeg + (hh >> 1) * 32, false); }
    }
    if (TAIL && wid == NWAVES - 1) {
        const int trow = lane >> 4, tc = (lane & 15) * 8;
        bf16x8 kn[8], vn[8];
#pragma unroll
        for (int i = 0; i < 8; ++i) { kn[i] = *(const bf16x8*)(Kn + (size_t)(4 * i + trow) * NS + tc); vn[i] = *(const bf16x8*)(Vn + (size_t)(4 * i + trow) * NS + tc); }
        const int tkb0 = trow * 256 + ((tc * 2) ^ (trow << 4)), tkb1 = trow * 256 + ((tc * 2) ^ (trow << 4) ^ 64);
        const int tvb = (tc >> 5) * 512 + trow * 64 + (tc & 31) * 2;
#pragma unroll
        for (int i = 0; i < 8; ++i) { *(bf16x8*)(Kl + ((i & 1) ? tkb1 : tkb0) + (4 * i) * 256) = kn[i]; *(bf16x8*)(Vl + tvb + (i & 1) * 2048 + (i >> 2) * 4096 + ((i >> 1) & 1) * 256) = vn[i]; }
        asm volatile("" ::: "memory");
        SQA_TILE(bias + NWAVES * KPW, true);
    }
    if (hi == 0) { MLm[wid * 32 + r32] = m_reg; MLl[wid * 32 + r32] = l_reg; }
    __syncthreads();
    { float M = -1e30f;
#pragma unroll
      for (int w = 0; w < NWAVES; ++w) M = fmaxf(M, MLm[w * 32 + r32]);
      float L = 0.f;
#pragma unroll
      for (int w = 0; w < NWAVES; ++w) L += MLl[w * 32 + r32] * __builtin_amdgcn_exp2f(MLm[w * 32 + r32] - M);
      const float f = __builtin_amdgcn_exp2f(m_reg - M) / L;
      if (hi == 0) fs[r32] = f; LDS_WAIT(); }
    { float* Op = (float*)(lds + wid * 16384);
#pragma unroll
      for (int d0 = 0; d0 < 4; ++d0)
#pragma unroll
          for (int r = 0; r < 16; ++r) Op[crow(r, hi) * 128 + d0 * 32 + r32] = o[d0][r] * fs[crow(r, hi)]; }
    __syncthreads();
    { const int row = tid >> 4, c8 = (tid & 15) * 8; f32x4 a0 = {0.f, 0.f, 0.f, 0.f}, a1 = {0.f, 0.f, 0.f, 0.f};
#pragma unroll
      for (int w = 0; w < NWAVES; ++w) { const float* s = (const float*)(lds + w * 16384) + row * 128 + c8; a0 += *(const f32x4*)s; a1 += *(const f32x4*)(s + 4); }
      *(u32x4*)(O + (size_t)row * OS + c8) = pack8(a0, a1); }
    __syncthreads();
#undef SQA_LOADH
#undef SQA_TRRD
#undef SQA_TILE
}
}
#undef KSWZ

#ifndef MK_N_LAUNCHES
#define MK_N_LAUNCHES 1
#endif
constexpr int N_PHASES = 11;
constexpr int N_LAUNCHES = MK_N_LAUNCHES;

__device__ __forceinline__ void load_row(const float* xrow, int lane, f32x4 (&v)[8]) {
    const f32x4* xr = (const f32x4*)xrow + lane;
#pragma unroll
    for (int j = 0; j < 8; ++j) v[j] = xr[64 * j];
}
__device__ __forceinline__ float norm_row(f32x4 (&v)[8], const f32x4 (&g)[8], bf16_t* orow, int lane) {
    float s = 0.f;
#pragma unroll
    for (int j = 0; j < 8; ++j) s += (v[j][0] * v[j][0] + v[j][1] * v[j][1]) + (v[j][2] * v[j][2] + v[j][3] * v[j][3]);
    const float r = __builtin_amdgcn_rsqf(wave_sum(s) * (1.0f / DM) + RMS_EPS);
    u32x2* o8 = (u32x2*)orow + lane;
#pragma unroll
    for (int j = 0; j < 8; ++j) { v[j] = v[j] * r * g[j]; u32x2 w; w.x = cvt_pk_bf16(v[j][0], v[j][1]); w.y = cvt_pk_bf16(v[j][2], v[j][3]); o8[64 * j] = w; }
    return r;
}

__global__ void __launch_bounds__(NWAVES * 64, 2) fox_fwd(Args args) {
    extern __shared__ __attribute__((aligned(16))) unsigned char lds[];
    const int tid = threadIdx.x, lane = tid & 63, wave = __builtin_amdgcn_readfirstlane(tid >> 6);
    const int G = gridDim.x; const int bx = blockIdx.x; const int vcu = (G % 8 == 0) ? (bx % 8) * (G / 8) + bx / 8 : bx;
    unsigned char* ws = args.ws; float* out = args.out;
    gu32* ctl = (gu32*)(ws + WS_CTL);
    volatile LAS unsigned* MISC = (volatile LAS unsigned*)((LAS unsigned char*)lds + MISC_OFF);
    for (int u = tid; u < (LDS_BYTES - LDSCTL_OFF) / 4; u += NWAVES * 64) ((LAS unsigned*)((LAS unsigned char*)lds + LDSCTL_OFF))[u] = 0u;
    __syncthreads();
    XcdBarrier bar; bar.bar = (unsigned*)(ctl + CW_BAR); bar.x = 0; bar.st = nullptr;
    if (N_LAUNCHES == 1) bar = xcd_barrier_post((unsigned*)(ctl + CW_BAR), MISC + 8);
    const int lo = args.ph_lo, hi_ph = args.ph_hi;
#ifndef PH_MASK
#define PH_MASK 0x7ff
#endif
#define IN(k) (((PH_MASK >> (k)) & 1) && lo <= (k) && (k) < hi_ph)
#define GRID_BAR(k) do { if (IN(k) && IN((k) + 1)) xcd_barrier(bar); } while (0)
    bf16_t* Win_t = (bf16_t*)(ws + WS_WIN); bf16_t* Wout_t = (bf16_t*)(ws + WS_WOUT); bf16_t* Wxq_t = (bf16_t*)(ws + WS_WXQ); bf16_t* Wxkv_t = (bf16_t*)(ws + WS_WXKV);
    bf16_t* Wxo_t = (bf16_t*)(ws + WS_WXO); bf16_t* Wup_t = (bf16_t*)(ws + WS_WUP); bf16_t* Wdn_t = (bf16_t*)(ws + WS_WDN);
    bf16_t* XN = (bf16_t*)(ws + WS_XN); bf16_t* MEMN = (bf16_t*)(ws + WS_MEMN); float* X1 = (float*)(ws + WS_X1); float* LOGF = (float*)(ws + WS_LOGF);
    float* BIASP = (float*)(ws + WS_BIASP); float* BIASS = (float*)(ws + WS_BIASS); float* SS1 = (float*)(ws + WS_SS); float* SS2 = SS1 + 32 * MT; float* SS3 = SS2 + 32 * MT;
    bf16_t* MKP = (bf16_t*)(ws + WS_MKP); bf16_t* GB = (bf16_t*)(ws + WS_GB); bf16_t* U = (bf16_t*)(ws + WS_U); bf16_t* QB = (bf16_t*)(ws + WS_Q); bf16_t* KB = (bf16_t*)(ws + WS_K);
    bf16_t* VB = (bf16_t*)(ws + WS_V); bf16_t* MIX = (bf16_t*)(ws + WS_MIX); bf16_t* QX = (bf16_t*)(ws + WS_QX); bf16_t* OX = (bf16_t*)(ws + WS_OX); bf16_t* HB = (bf16_t*)(ws + WS_H); bf16_t* PART = (bf16_t*)(ws + WS_PART); bf16_t* WoutR = (bf16_t*)(ws + WS_WOUTR); float* R0 = (float*)(ws + WS_R0); float* QPRE = (float*)(ws + WS_QPRE);
    const int gw = vcu * NWAVES + wave, NGW = G * NWAVES;
    LAS unsigned char* ldsl = (LAS unsigned char*)lds;

    if (IN(0)) {
        LAS float* wf = (LAS float*)(ldsl + 65536);
        { const float* W = args.in[I_WIN];
          for (int i0 = 0; i0 < 32; i0 += 8) { float t[8];
#pragma unroll
              for (int e = 0; e < 8; ++e) { const int idx = tid + (i0 + e) * (NWAVES * 64); t[e] = W[(size_t)(idx >> 3) * DIN + NIN + (idx & 7)]; }
#pragma unroll
              for (int e = 0; e < 8; ++e) { const int idx = tid + (i0 + e) * (NWAVES * 64); wf[(idx & 7) * DM + (idx >> 3)] = t[e]; } } }
        __syncthreads();
        f32x4 gmix[8]; load_row(args.in[I_GMIX], lane, gmix);
        const float bfl = args.in[I_BF][lane >> 3];
        f32x4 vn[8]; if (gw < MT) load_row((gw < MP) ? args.in[I_XP] + (size_t)gw * DM : args.in[I_XS] + (size_t)(gw - MP) * DM, lane, vn);
        for (int m = gw; m < MT; m += NGW) {
            f32x4 v[8];
#pragma unroll
            for (int j = 0; j < 8; ++j) v[j] = vn[j];
            { const int mn_ = m + NGW; if (mn_ < MT) load_row((mn_ < MP) ? args.in[I_XP] + (size_t)mn_ * DM : args.in[I_XS] + (size_t)(mn_ - MP) * DM, lane, vn); }
            const float r0 = norm_row(v, gmix, XN + (size_t)m * DM, lane); if (lane == 0) R0[m] = r0;
            float z[8];
#pragma unroll
            for (int h = 0; h < 8; ++h) { float a = 0.f;
#pragma unroll
                for (int j = 0; j < 8; ++j) { const f32x4 w = *(const LAS f32x4*)(wf + h * DM + 256 * j + 4 * lane); a += (v[j][0] * w[0] + v[j][1] * w[1]) + (v[j][2] * w[2] + v[j][3] * w[3]); }
                z[h] = a; }
            float zz;
            { const bool u5 = (lane & 32) != 0, u4 = (lane & 16) != 0, u3 = (lane & 8) != 0; float b4[4], b2[2];
#pragma unroll
              for (int i = 0; i < 4; ++i) { const float keep = u5 ? z[4 + i] : z[i], give = u5 ? z[i] : z[4 + i]; b4[i] = keep + __shfl_xor(give, 32); }
#pragma unroll
              for (int i = 0; i < 2; ++i) { const float keep = u4 ? b4[2 + i] : b4[i], give = u4 ? b4[i] : b4[2 + i]; b2[i] = keep + __shfl_xor(give, 16); }
              { const float keep = u3 ? b2[1] : b2[0], give = u3 ? b2[0] : b2[1]; zz = keep + __shfl_xor(give, 8); }
              zz += __shfl_xor(zz, 4); zz += __shfl_xor(zz, 2); zz += __shfl_xor(zz, 1); }
            if ((lane & 7) == 0) { const int hh_ = lane >> 3;
                const float lf = log_sigmoidf(zz + bfl);
                LOGF[(size_t)m * NH + hh_] = lf;
                if (m < MP) out[O_FP + (size_t)m * NH + hh_] = lf; else out[O_FS + (size_t)(m - MP) * NH + hh_] = lf; }
        }
        { f32x4 gmem[8]; load_row(args.in[I_GMEM], lane, gmem);
          for (int m = gw; m < NB_P * NMEM; m += NGW) { f32x4 v[8]; load_row(args.in[I_MEMP] + (size_t)m * DM, lane, v); (void)norm_row(v, gmem, MEMN + (size_t)m * DM, lane); } }
        for (int k = gw; k < DM; k += NGW) {
            const float g = (k < DCONV) ? args.in[I_GCONV][k] : args.in[I_GATTN][k - DCONV];
            f32x4 w8[8]; load_row(args.in[I_WOUT] + (size_t)k * DM, lane, w8); u32x2* o8 = (u32x2*)(WoutR + (size_t)k * DM) + lane;
#pragma unroll
            for (int j = 0; j < 8; ++j) { const f32x4 w = w8[j] * g; u32x2 o; o.x = cvt_pk_bf16(w[0], w[1]); o.y = cvt_pk_bf16(w[2], w[3]); o8[64 * j] = o; }
        }
        constexpr int I_IN = (DM / 64) * (NIN / 64), I_XQ = (DM / 64) * (DX / 64), I_XKV = (DM / 64) * (2 * DX / 64),
                      NITEMS = I_IN + 2 * I_XQ + I_XKV;
        for (int it = gw; it < NITEMS; it += NGW) {
            int r = it;
            if (r < I_IN) { const int nb = NIN / 64, kb = r / nb, n0 = (r % nb) * 64; p0_transpose_item(args.in[I_WIN], DM, DIN, Win_t, kb * 64, n0, win_drow(n0), nullptr, nullptr, lane); continue; } r -= I_IN;
            if (r < I_XQ) { const int nb = DX / 64, kb = r / nb, n0 = (r % nb) * 64; p0_transpose_item(args.in[I_WXQ], DM, DX, Wxq_t, kb * 64, n0, n0, args.in[I_GXATTN], nullptr, lane); continue; } r -= I_XQ;
            if (r < I_XQ) { const int nb = DX / 64, kb = r / nb, n0 = (r % nb) * 64; p0_transpose_item(args.in[I_WXQ], DM, DX, Win_t, kb * 64, n0, NIN + n0, args.in[I_GXATTN], args.in[I_GMIX], lane); continue; } r -= I_XQ;
            { const int nb = 2 * DX / 64, kb = r / nb, n0 = (r % nb) * 64; p0_transpose_item(args.in[I_WXKV], DM, 2 * DX, Wxkv_t, kb * 64, n0, n0, nullptr, nullptr, lane); }
        }
        __syncthreads();
    }
    GRID_BAR(0);

    if (IN(1)) {
        { pg8::Gemm g{XN, Win_t, DM, DM}; pg8::StaticOrder S; S.init(MT, NIN + DX, G, bx);
          EpiWin E{GB, U, QB, KB, VB, out, R0, QPRE};
          pg8::gemm_phase(ldsl, g, S, E); }
        { pg8::Gemm g{Wxq_t, WoutR, DM, DM}; pg8::TailOrder S{8, 16, G, bx, 8};
          EpiPlain E{Wout_t + (size_t)DM * DM, DM};
          pg8::gemm_phase(ldsl, g, S, E); }
        { pg8::Gemm g{MEMN, Wxkv_t, DM, DM}; pg8::TailOrder S{4, 8, G, bx, 0};
          EpiMem E{MKP, out};
          pg8::gemm_phase(ldsl, g, S, E); }
        { LAS float* scr = (LAS float*)ldsl;
          int s0 = ((MT / 256) * ((NIN + DX) / 256)) % G, s1 = G - 24; if (s1 - s0 < 8) { s0 = 0; s1 = G; }
          const int ns = s1 - s0;
          if (bx >= s0 && bx < s1) { constexpr int I_OUT = (DM / 64) * (DM / 64), I_XO = (DX / 64) * (DM / 64);
              for (int it = (bx - s0) * NWAVES + wave; it < I_OUT + I_XO; it += ns * NWAVES) {
                  if (it < I_OUT) { const int nb = DM / 64, kb = it / nb, n0 = (it % nb) * 64; const float* g = (kb * 64 < DCONV) ? args.in[I_GCONV] : args.in[I_GATTN] - DCONV;
                      p0_transpose_item(args.in[I_WOUT], DM, DM, Wout_t, kb * 64, n0, n0, g, nullptr, lane); }
                  else { const int r = it - I_OUT, nb = DM / 64, kb = r / nb, n0 = (r % nb) * 64; p0_transpose_item(args.in[I_WXO], DX, DM, Wxo_t, kb * 64, n0, n0, nullptr, nullptr, lane); } } }
          if (bx >= s0 && bx < s1) for (int it = bx - s0; it < NB_S * NH + NB_P * NH; it += ns) {
            if (it < NB_S * NH) {
                const int b = it >> 3, h = it & 7; const float* lf = args.in[I_CLF] + (size_t)b * PAST * NH + h; float* bo = BIASS + (size_t)it * SKEYS;
                float v[4]; float T = 0.f;
#pragma unroll
                for (int e = 0; e < 4; ++e) { const int jp = 4 * tid + e; v[e] = lf[(size_t)(PAST - 1 - jp) * NH]; T += v[e]; }
                float run = block_excl_prefix(T, scr, wave, lane);
#pragma unroll
                for (int e = 0; e < 4; ++e) { const int jp = 4 * tid + e; bo[PAST - 1 - jp] = LOG2E * run; run += v[e]; }
                if (tid < 64) { const int i = lane & 31; float x = LOGF[(size_t)(MP + b * DSEQ + i) * NH + h];
#pragma unroll
                    for (int o = 1; o < 32; o <<= 1) { const float x2 = __shfl_up(x, o); if (i >= o) x += x2; }
                    if (lane < 32) bo[PAST + i] = -LOG2E * x; }
            } else {
                const int ip = it - NB_S * NH, b = ip >> 3, h = ip & 7; const float* lf = LOGF + (size_t)b * SEQ * NH + h; float* bo = BIASP + (size_t)ip * SEQ;
                float v[8]; float T = 0.f;
#pragma unroll
                for (int e = 0; e < 8; ++e) { v[e] = lf[(size_t)(8 * tid + e) * NH]; T += v[e]; }
                float run = block_excl_prefix(T, scr, wave, lane);
#pragma unroll
                for (int e = 0; e < 8; ++e) { run += v[e]; bo[8 * tid + e] = -LOG2E * run; }
            }
          }
        }
    }
    GRID_BAR(1);

    if (IN(2)) {
        const bool xsplit = (G == 256); const int sidx = xsplit ? (vcu >> 5) * 16 + (vcu & 15) : vcu; const bool sside = xsplit ? ((vcu & 16) != 0) : true;
        for (int it0 = vcu; it0 < 256; it0 += G) { const int it = xsplit ? (sside ? 128 + sidx : sidx) : it0;
            if (it < 128) {
#ifndef DBG_NO_ATT
                const int bh = it >> 3, x = it & 7, b = bh >> 3, h = bh & 7;
                const size_t hb = (size_t)b * SEQ * DATT + h * HD;
                att::BlockRef r0{QB + hb + (size_t)x * 256 * DATT, KB + hb, VB + hb, MIX + (size_t)b * SEQ * DM + DCONV + h * HD + (size_t)x * 256 * DM, BIASP + (size_t)bh * SEQ, x * 256, SEQ, nullptr, 0};
                att::BlockRef r1 = r0; const int y = 15 - x; r1.Q = QB + hb + (size_t)y * 256 * DATT; r1.O = MIX + (size_t)b * SEQ * DM + DCONV + h * HD + (size_t)y * 256 * DM; r1.P0 = y * 256;
                att::Seam S;
                att::attn_prime<DATT, DATT, true>(r0, (char*)lds, S);
                att::attn_block<DATT, DATT, DM, true>(r0, r1, (char*)lds, S);
                att::attn_block<DATT, DATT, DM, true>(r1, r1, (char*)lds, S);
                VM_WAIT(); __syncthreads();
#endif
            } else {
#ifndef DBG_NO_SQA
                for (int k = 0; k < 2; ++k) { const int sh = (it - 128) * 2 + k, b = sh >> 3, h = sh & 7;
                    const size_t row0 = (size_t)(MP + b * DSEQ);
                    sqa::item<true, true>(QB + row0 * DATT + h * HD, DATT, args.in[I_CK] + (size_t)b * PAST * DATT + h * HD, args.in[I_CV] + (size_t)b * PAST * DATT + h * HD, DATT, PAST / NWAVES,
                                          KB + row0 * DATT + h * HD, VB + row0 * DATT + h * HD, DATT, BIASS + (size_t)sh * SKEYS, MIX + row0 * DM + DCONV + h * HD, DM, (char*)lds, nullptr, 0); }
#endif
            }
        }
        { const int nc = xsplit ? 128 : G;
          if (sside) {
            const float* cw = args.in[I_CONVW];
            float w0[16], w1[16], w2[16];
#pragma unroll
            for (int e = 0; e < 16; ++e) { w0[e] = cw[16 * lane + e]; w1[e] = cw[DCONV + 16 * lane + e]; w2[e] = cw[2 * DCONV + 16 * lane + e]; }
            for (int m = sidx * NWAVES + wave; m < MT; m += nc * NWAVES) {
                int t, b; bool smp = m >= MP; if (!smp) { b = m / SEQ; t = m % SEQ; } else { b = (m - MP) / DSEQ; t = (m - MP) % DSEQ; }
                float um[16], u1[16], u2[16], gbv[16];
                { const bf16x8* p = (const bf16x8*)(U + (size_t)m * DCONV + 16 * lane); const bf16x8 a = p[0], c = p[1];
#pragma unroll
                  for (int e = 0; e < 8; ++e) { um[e] = bf2f((unsigned short)a[e]); um[8 + e] = bf2f((unsigned short)c[e]); }
                  const bf16x8* q = (const bf16x8*)(GB + (size_t)m * DCONV + 16 * lane); const bf16x8 ga = q[0], gc = q[1];
#pragma unroll
                  for (int e = 0; e < 8; ++e) { gbv[e] = bf2f((unsigned short)ga[e]); gbv[8 + e] = bf2f((unsigned short)gc[e]); } }
#define CONV_PREV(dst, back) do { if (t >= (back)) { const bf16x8* p = (const bf16x8*)(U + (size_t)(m - (back)) * DCONV + 16 * lane); const bf16x8 a = p[0], c = p[1];           \
                _Pragma("unroll") for (int e = 0; e < 8; ++e) { dst[e] = bf2f((unsigned short)a[e]); dst[8 + e] = bf2f((unsigned short)c[e]); } }                                \
            else if (smp) { const float* p = args.in[I_CCONV] + ((size_t)b * 2 + (2 + t - (back))) * DCONV + 16 * lane; _Pragma("unroll") for (int e = 0; e < 16; ++e) dst[e] = p[e]; } \
            else { _Pragma("unroll") for (int e = 0; e < 16; ++e) dst[e] = 0.f; } } while (0)
                CONV_PREV(u1, 1); CONV_PREV(u2, 2);
#undef CONV_PREV
                float yc[16]; float s = 0.f;
#pragma unroll
                for (int e = 0; e < 16; ++e) { yc[e] = gbv[e] * (w0[e] * u2[e] + w1[e] * u1[e] + w2[e] * um[e]); s += yc[e] * yc[e]; }
                const float rc = __builtin_amdgcn_rsqf(wave_sum(s) * (1.0f / DCONV) + RMS_EPS);
                u32x4 o0, o1;
                o0.x = cvt_pk_bf16(yc[0] * rc, yc[1] * rc); o0.y = cvt_pk_bf16(yc[2] * rc, yc[3] * rc); o0.z = cvt_pk_bf16(yc[4] * rc, yc[5] * rc); o0.w = cvt_pk_bf16(yc[6] * rc, yc[7] * rc);
                o1.x = cvt_pk_bf16(yc[8] * rc, yc[9] * rc); o1.y = cvt_pk_bf16(yc[10] * rc, yc[11] * rc); o1.z = cvt_pk_bf16(yc[12] * rc, yc[13] * rc); o1.w = cvt_pk_bf16(yc[14] * rc, yc[15] * rc);
                u32x4* mo = (u32x4*)(MIX + (size_t)m * DM + 16 * lane); mo[0] = o0; mo[1] = o1;
            } } }
        { const int nc = xsplit ? 128 : G;
          if (sside) for (int m = sidx * NWAVES + wave; m < MT; m += nc * NWAVES) {
              const int isv = 0, row = m;
              const u32x2* src = (const u32x2*)((isv ? VB : KB) + (size_t)row * DATT) + lane;
              float* dstp = out + (row < MP ? (isv ? O_VP : O_KP) + (size_t)row * DATT : (isv ? O_VS : O_KS) + (size_t)(row - MP) * DATT);
              u32x2 w[4];
#pragma unroll
              for (int j = 0; j < 4; ++j) w[j] = src[64 * j];
#pragma unroll
              for (int j = 0; j < 4; ++j) ((f32x4*)dstp)[64 * j + lane] = (f32x4){__uint_as_float(w[j].x << 16), __uint_as_float(w[j].x & 0xffff0000u), __uint_as_float(w[j].y << 16), __uint_as_float(w[j].y & 0xffff0000u)};
          } }
    }
    GRID_BAR(2);

    if (IN(3)) {
        for (int row = gw; row < MT; row += NGW) {
            const u32x2* src = (const u32x2*)(VB + (size_t)row * DATT) + lane;
            float* dstp = out + (row < MP ? O_VP + (size_t)row * DATT : O_VS + (size_t)(row - MP) * DATT);
            u32x2 w[4];
#pragma unroll
            for (int j = 0; j < 4; ++j) w[j] = src[64 * j];
#pragma unroll
            for (int j = 0; j < 4; ++j) ((f32x4*)dstp)[64 * j + lane] = (f32x4){__uint_as_float(w[j].x << 16), __uint_as_float(w[j].x & 0xffff0000u), __uint_as_float(w[j].y << 16), __uint_as_float(w[j].y & 0xffff0000u)};
        }
        for (int m = gw; m < MT; m += NGW) {
            u32x4* ma = (u32x4*)(MIX + (size_t)m * DM + DCONV + 16 * lane); const bf16x8 a = ((const bf16x8*)ma)[0], c = ((const bf16x8*)ma)[1];
            float ya[16]; float sa = 0.f;
#pragma unroll
            for (int e = 0; e < 8; ++e) { ya[e] = bf2f((unsigned short)a[e]); ya[8 + e] = bf2f((unsigned short)c[e]); }
#pragma unroll
            for (int e = 0; e < 16; ++e) sa += ya[e] * ya[e];
            const float ra = __builtin_amdgcn_rsqf(wave_sum(sa) * (1.0f / DATT) + RMS_EPS);
            u32x4 o0, o1;
            o0.x = cvt_pk_bf16(ya[0] * ra, ya[1] * ra); o0.y = cvt_pk_bf16(ya[2] * ra, ya[3] * ra); o0.z = cvt_pk_bf16(ya[4] * ra, ya[5] * ra); o0.w = cvt_pk_bf16(ya[6] * ra, ya[7] * ra);
            o1.x = cvt_pk_bf16(ya[8] * ra, ya[9] * ra); o1.y = cvt_pk_bf16(ya[10] * ra, ya[11] * ra); o1.z = cvt_pk_bf16(ya[12] * ra, ya[13] * ra); o1.w = cvt_pk_bf16(ya[14] * ra, ya[15] * ra);
            ma[0] = o0; ma[1] = o1;
        }
    }
    GRID_BAR(3);

    if (IN(4)) { pg8::Gemm g{MIX, Wout_t, DM, DM}; pg8::StaticOrder S; S.init(MT, DM + DX, G, bx);
        EpiRes<0> E{args.in[I_XP], args.in[I_XS], XN, SS1, QPRE, QX};
        pg8::gemm_phase(ldsl, g, S, E);
        { const int nbusy = (MT / 256) * ((DM + DX) / 256) - G; const bool part = nbusy >= 0 && nbusy < G; const int nidle = part ? G - nbusy : G;
          if (!part || bx >= nbusy) { constexpr int I_UP = (DM / 64) * (DFF / 64);
              for (int it = (part ? bx - nbusy : bx) * NWAVES + wave; it < I_UP; it += nidle * NWAVES) { const int nb = DFF / 64, kb = it / nb, n0 = (it % nb) * 64;
                  p0_transpose_item(args.in[I_WUP], DM, DFF, Wup_t, kb * 64, n0, n0, args.in[I_GMLP], nullptr, lane); } } }
    }
    GRID_BAR(4);
    if (IN(6)) {
        for (int it = vcu; it < 256; it += G) {
            if (it < 128) { const int qb = it >> 2, h = it & 3, b = qb >> 4;
                att::BlockRef r0{QX + (size_t)qb * 256 * DX + h * HD, MKP + (size_t)b * NMEM * DX + h * HD, MKP + 512 * 512 + (size_t)b * NMEM * DX + h * HD, OX + (size_t)qb * 256 * DX + h * HD, nullptr, 1 << 24, NMEM, SS1, qb * 256};
                att::Seam S;
                att::attn_prime<DX, DX, false>(r0, (char*)lds, S);
                att::attn_block<DX, DX, DX, false>(r0, r0, (char*)lds, S);
                VM_WAIT(); __syncthreads();
            } else { const int sh = it - 128, b = sh >> 2, h = sh & 3; const size_t row0 = (size_t)(MP + b * DSEQ);
                sqa::item<false, false>(QX + row0 * DX + h * HD, DX, args.in[I_CMK] + (size_t)b * NMEM * DX + h * HD, args.in[I_CMV] + (size_t)b * NMEM * DX + h * HD, DX, NMEM / NWAVES,
                                        nullptr, nullptr, 0, nullptr, OX + row0 * DX + h * HD, DX, (char*)lds, SS1, (int)row0); }
        }
    }
    GRID_BAR(6);
    if (IN(7)) { pg8::Gemm g{OX, Wxo_t, DX, DX}; pg8::StaticOrder S; S.init(MT, DM, G, bx);
        EpiRes<1> E{nullptr, nullptr, XN, SS2, nullptr, nullptr};
        pg8::gemm_phase(ldsl, g, S, E);
        { const int nun = (MT / 256) * (DM / 256), nbusy = nun % G; const bool part = nun > G && nbusy > 0; const int nidle = part ? G - nbusy : G;
          if (!part || bx >= nbusy) { constexpr int I_DN = (DFF / 64) * (DM / 64);
              for (int it = (part ? bx - nbusy : bx) * NWAVES + wave; it < I_DN / 2; it += nidle * NWAVES) { const int nb = DM / 64, kb = it / nb, n0 = (it % nb) * 64;
                  p0_transpose_item(args.in[I_WDN], DFF, DM, Wdn_t, kb * 64, n0, n0, nullptr, nullptr, lane); } } }
    }
    GRID_BAR(7);
    if (IN(8)) { pg8::Gemm g{XN, Wup_t, DM, DM}; pg8::StaticOrder S; S.init(MT, DFF, G, bx);
        EpiScale<1> E{HB, DFF, SS2};
        pg8::gemm_phase(ldsl, g, S, E);
        { const int nun = (MT / 256) * (DFF / 256), nbusy = nun % G; const bool part = nbusy > 0; const int nidle = part ? G - nbusy : G;
          if (!part || bx >= nbusy) { constexpr int I_DN = (DFF / 64) * (DM / 64);
              for (int it = I_DN / 2 + (part ? bx - nbusy : bx) * NWAVES + wave; it < I_DN; it += nidle * NWAVES) { const int nb = DM / 64, kb = it / nb, n0 = (it % nb) * 64;
                  p0_transpose_item(args.in[I_WDN], DFF, DM, Wdn_t, kb * 64, n0, n0, nullptr, nullptr, lane); } } }
    }
    GRID_BAR(8);
    if (IN(9)) {
        { pg8::Gemm g{HB, Wdn_t, DFF, DFF}; pg8::StaticOrder S; S.init(MP, DM, G, bx);
          EpiRes<1> E{nullptr, nullptr, XN, SS3, nullptr, nullptr};
          pg8::gemm_phase(ldsl, g, S, E); }
        { pg8::Gemm g{HB, Wdn_t, DFF, DFF / 8}; pg8::SplitOrder S{MP / 256, DM / 256, (MS / 256) * (DM / 256), 8, DFF / 8, G, bx};
          EpiPart E{PART, MP, MS, DFF / 8};
          pg8::gemm_phase(ldsl, g, S, E); }
    }
    GRID_BAR(9);
    if (IN(10)) {
        f32x4 gfin[8]; load_row(args.in[I_GFINAL], lane, gfin);
        for (int m = gw; m < MT; m += NGW) {
            const u32x2* xr = (const u32x2*)(XN + (size_t)m * DM) + lane; f32x4* yo = (f32x4*)(out + (size_t)m * DM) + lane;
            f32x4 v[8];
#pragma unroll
            for (int j = 0; j < 8; ++j) { const u32x2 w = xr[64 * j]; v[j] = (f32x4){__uint_as_float(w.x << 16), __uint_as_float(w.x & 0xffff0000u), __uint_as_float(w.y << 16), __uint_as_float(w.y & 0xffff0000u)}; }
            float r;
            if (m < MP) {
                float s = (lane < 32) ? SS3[(size_t)lane * MT + m] : 0.f;
                r = __builtin_amdgcn_rsqf(wave_sum(s) * (1.0f / DM) + RMS_EPS);
            } else {
                float s = 0.f;
#pragma unroll
                for (int j = 0; j < 8; ++j) {
#pragma unroll
                    for (int sl = 0; sl < 8; ++sl) { const u32x2 w = ((const u32x2*)(PART + ((size_t)sl * MS + (m - MP)) * DM))[64 * j + lane];
                        v[j] += (f32x4){__uint_as_float(w.x << 16), __uint_as_float(w.x & 0xffff0000u), __uint_as_float(w.y << 16), __uint_as_float(w.y & 0xffff0000u)}; }
                    s += (v[j][0] * v[j][0] + v[j][1] * v[j][1]) + (v[j][2] * v[j][2] + v[j][3] * v[j][3]); }
                r = __builtin_amdgcn_rsqf(wave_sum(s) * (1.0f / DM) + RMS_EPS);
            }
#pragma unroll
            for (int j = 0; j < 8; ++j) yo[64 * j] = v[j] * r * gfin[j];
        }
    }
#undef IN
#undef GRID_BAR
}

extern "C" void kernel_launch(void* const* d_in, const int* in_sizes, int n_in, void* d_out, int out_size, void* d_ws, size_t ws_size, hipStream_t stream) {
    static int grid = 0;
    if (grid == 0) {
        if (n_in != 25 || (size_t)out_size != O_END || ws_size < WS_END) { fprintf(stderr, "kernel_launch: unexpected shapes (n_in %d, out %d, ws %zu)\n", n_in, out_size, ws_size); grid = -1; return; }
        int dev = 0, cus = 0;
        if (hipGetDevice(&dev) != hipSuccess || hipDeviceGetAttribute(&cus, hipDeviceAttributeMultiprocessorCount, dev) != hipSuccess) { grid = -1; return; }
        if (hipFuncSetAttribute((const void*)fox_fwd, hipFuncAttributeMaxDynamicSharedMemorySize, LDS_BYTES) != hipSuccess) { fprintf(stderr, "kernel_launch: hipFuncSetAttribute failed\n"); grid = -1; return; }
        (void)hipGetLastError();
        grid = cus;
    }
    if (grid < 0) return;
    if (hipMemsetAsync((char*)d_ws + WS_CTL, 0, CTL_ZERO_BYTES, stream) != hipSuccess) return;
    Args a{};
    for (int i = 0; i < 25; ++i) a.in[i] = (const float*)d_in[i];
    a.out = (float*)d_out; a.ws = (unsigned char*)d_ws;
    if (N_LAUNCHES == 1) { a.ph_lo = 0; a.ph_hi = N_PHASES; hipLaunchKernelGGL(fox_fwd, dim3(grid), dim3(NWAVES * 64), LDS_BYTES, stream, a); }
    else { for (int p = 0; p < N_PHASES; ++p) { a.ph_lo = p; a.ph_hi = p + 1; hipLaunchKernelGGL(fox_fwd, dim3(grid), dim3(NWAVES * 64), LDS_BYTES, stream, a); } }
}
```
